# Optimizing an MI355X kernel written in HIP

```python
import math
import jax, jax.numpy as jnp
from jax import lax
import numpy as np

D_MODEL = 1024
BATCH = 4
SEQ = 4096
DEPTH = 1
DEC_BATCH = 8
DEC_SEQ = 32
PAST_LEN = 2048

CHUNK = 64
WINDOW = 128
WINDOW_CHUNKS = WINDOW // CHUNK

ATTN_HEAD_DIM = 64
ATTN_WIDTH = D_MODEL // 2
ATTN_HEADS = ATTN_WIDTH // ATTN_HEAD_DIM
ATTN_KV_HEADS = 2
ATTN_GROUP = ATTN_HEADS // ATTN_KV_HEADS
KV_WIDTH = ATTN_KV_HEADS * ATTN_HEAD_DIM

RWKV_HEAD_DIM = 64
RWKV_WIDTH = D_MODEL - ATTN_WIDTH
RWKV_HEADS = RWKV_WIDTH // RWKV_HEAD_DIM
DECAY_LORA = 64
AAA_LORA = 64
GATE_LORA = 128
RWKV_PROJ = 3 * RWKV_WIDTH + DECAY_LORA + AAA_LORA + GATE_LORA
RWKV_SPLITS = (RWKV_WIDTH, 2 * RWKV_WIDTH, 3 * RWKV_WIDTH,
               3 * RWKV_WIDTH + DECAY_LORA, 3 * RWKV_WIDTH + DECAY_LORA + AAA_LORA)

MIX_WIDTH = ATTN_WIDTH + RWKV_WIDTH
IN_PROJ = ATTN_WIDTH + 2 * KV_WIDTH + RWKV_PROJ

N_MEM = 256
MEM_HEADS = 4
MEM_HEAD_DIM = 128
MEM_WIDTH = MEM_HEADS * MEM_HEAD_DIM

D_FF = 4 * D_MODEL
REL_BUCKETS = 32
REL_MAX_DIST = 128
NORM_EPS = 1e-6
GN_EPS = 64e-5

kernel_name = 'hymba_swa_sink_rwkv7_stream_step'


def rmsnorm(x, g):
    x32 = x.astype(jnp.float32)
    y = x32 * lax.rsqrt(jnp.mean(x32 * x32, axis=-1, keepdims=True) + NORM_EPS)
    return (y * g.astype(jnp.float32)).astype(x.dtype)


def t5_bucket(rel):
    half = REL_BUCKETS // 2
    max_exact = half // 2
    n = jnp.abs(rel)
    large = max_exact + (jnp.log(jnp.maximum(n, 1).astype(jnp.float32) / max_exact)
                         / math.log(REL_MAX_DIST / max_exact) * (half - max_exact)).astype(jnp.int32)
    large = jnp.minimum(large, half - 1)
    return jnp.where(rel > 0, half, 0) + jnp.where(n < max_exact, n, large)


def rel_bias(rel, table):
    b = table[t5_bucket(rel)]
    return jnp.transpose(b, (2, 0, 1)).reshape(ATTN_KV_HEADS, ATTN_GROUP, rel.shape[0], rel.shape[1])


def sink_attention(q, k, v, bias, valid, sink):
    s = jnp.einsum('bcqhgd,bckhd->bchgqk', q, k).astype(jnp.float32) * (ATTN_HEAD_DIM ** -0.5)
    s = s + bias.astype(jnp.float32)
    s = jnp.where(valid[None, :, None, None, None, :], s, -jnp.inf)
    sk = sink.astype(jnp.float32).reshape(1, 1, ATTN_KV_HEADS, ATTN_GROUP, 1, 1)
    m = jnp.maximum(jnp.max(s, axis=-1, keepdims=True), sk)
    p = jnp.exp(s - m)
    den = jnp.sum(p, axis=-1, keepdims=True) + jnp.exp(sk - m)
    return jnp.einsum('bchgqk,bckhd->bcqhgd', (p / den).astype(v.dtype), v)


def window_attention(q, k, v, k_past, v_past, sink, table):
    B, T = q.shape[0], q.shape[1]
    if k_past is None:
        nc = T // CHUNK
        qb = q.reshape(B, nc, CHUNK, ATTN_KV_HEADS, ATTN_GROUP, ATTN_HEAD_DIM)
        pad = ((0, 0), (WINDOW, 0), (0, 0), (0, 0))
        kp = jnp.pad(k, pad).reshape(B, nc + WINDOW_CHUNKS, CHUNK, ATTN_KV_HEADS, ATTN_HEAD_DIM)
        vp = jnp.pad(v, pad).reshape(B, nc + WINDOW_CHUNKS, CHUNK, ATTN_KV_HEADS, ATTN_HEAD_DIM)
        kb = jnp.concatenate([kp[:, i:i + nc] for i in range(WINDOW_CHUNKS + 1)], axis=2)
        vb = jnp.concatenate([vp[:, i:i + nc] for i in range(WINDOW_CHUNKS + 1)], axis=2)
        n_q, n_k = CHUNK, WINDOW + CHUNK
        valid = (jnp.arange(nc)[:, None] * CHUNK - WINDOW + jnp.arange(n_k)[None, :]) >= 0
        k_buf, v_buf = k[:, -WINDOW:], v[:, -WINDOW:]
    else:
        kc = jnp.concatenate([k_past.astype(k.dtype), k], axis=1)
        vc = jnp.concatenate([v_past.astype(v.dtype), v], axis=1)
        qb = q.reshape(B, 1, T, ATTN_KV_HEADS, ATTN_GROUP, ATTN_HEAD_DIM)
        kb, vb = kc[:, None], vc[:, None]
        n_q, n_k = T, WINDOW + T
        valid = jnp.ones((1, n_k), dtype=bool)
        k_buf, v_buf = kc[:, -WINDOW:], vc[:, -WINDOW:]
    rel = jnp.arange(n_k)[None, :] - WINDOW - jnp.arange(n_q)[:, None]
    o = sink_attention(qb, kb, vb, rel_bias(rel, table), valid, sink)
    return o.reshape(B, T, ATTN_WIDTH), k_buf, v_buf


def wkv7_scan(r, w, k, v, a, b, state0):
    def step(S, inp):
        r_t, w_t, k_t, v_t, a_t, b_t = inp
        sa = jnp.einsum('bhij,bhj->bhi', S, a_t)
        S = S * w_t[:, :, None, :] + sa[..., None] * b_t[:, :, None, :] + v_t[..., None] * k_t[:, :, None, :]
        return S, jnp.einsum('bhij,bhj->bhi', S, r_t)
    xs = tuple(jnp.moveaxis(t.astype(jnp.float32), 1, 0) for t in (r, w, k, v, a, b))
    S, ys = lax.scan(step, state0.astype(jnp.float32), xs)
    return jnp.moveaxis(ys, 0, 1), S


def rwkv7_mixer(zr, shift_prev, wkv0, lw):
    B, T = zr.shape[0], zr.shape[1]
    f32 = jnp.float32
    z_prev = jnp.concatenate([shift_prev.astype(zr.dtype), zr[:, :-1]], axis=1)
    zs = zr + (z_prev - zr) * lw['rwkv_mu']
    r, k, v, wd, ad, gd = jnp.split(zs, RWKV_SPLITS, axis=-1)
    w_log = -jax.nn.softplus(-(lw['rwkv_w0'] + jnp.tanh(wd) @ lw['rwkv_w2'])) - 0.5
    decay = jnp.exp(-jnp.exp(w_log.astype(f32)))
    a = jax.nn.sigmoid(lw['rwkv_a0'] + ad @ lw['rwkv_a2'])
    g = jax.nn.sigmoid(gd) @ lw['rwkv_g2']
    heads = lambda t: t.reshape(B, T, RWKV_HEADS, RWKV_HEAD_DIM)
    kk = heads(k * lw['rwkv_k_k']).astype(f32)
    kk = kk / jnp.maximum(jnp.sqrt(jnp.sum(kk * kk, axis=-1, keepdims=True)), 1e-12)
    k = k * (1.0 + (a - 1.0) * lw['rwkv_k_a'])
    r_h, k_h, v_h, a_h = heads(r).astype(f32), heads(k).astype(f32), heads(v).astype(f32), heads(a).astype(f32)
    y, S = wkv7_scan(r_h, heads(decay), k_h, v_h, -kk, kk * a_h, wkv0)
    mu = jnp.mean(y, axis=-1, keepdims=True)
    var = jnp.mean(jnp.square(y - mu), axis=-1, keepdims=True)
    y = ((y - mu) * lax.rsqrt(var + GN_EPS)).reshape(B, T, RWKV_WIDTH)
    y = y * lw['rwkv_ln_w'].astype(f32) + lw['rwkv_ln_b'].astype(f32)
    bonus = jnp.sum(r_h * k_h * lw['rwkv_r_k'].astype(f32), axis=-1, keepdims=True) * v_h
    y = (y + bonus.reshape(B, T, RWKV_WIDTH)).astype(zr.dtype)
    return y * g, zr[:, -1:], S


def memory_kv(mem, lw):
    B = mem.shape[0]
    mn = rmsnorm(mem, lw['norm_mem_g'])
    mk = (mn @ lw['w_mk']).reshape(B, N_MEM, MEM_HEADS, MEM_HEAD_DIM)
    mv = (mn @ lw['w_mv']).reshape(B, N_MEM, MEM_HEADS, MEM_HEAD_DIM)
    return mk, mv


def memory_cross_attention(h, mem_k, mem_v, lw):
    B, T = h.shape[0], h.shape[1]
    q = (h @ lw['w_cq']).reshape(B, T, MEM_HEADS, MEM_HEAD_DIM)
    s = jnp.einsum('bthd,bmhd->bhtm', q, mem_k.astype(h.dtype)).astype(jnp.float32) * (MEM_HEAD_DIM ** -0.5)
    p = jax.nn.softmax(s, axis=-1).astype(h.dtype)
    o = jnp.einsum('bhtm,bmhd->bthd', p, mem_v.astype(h.dtype)).reshape(B, T, MEM_WIDTH)
    return o @ lw['w_co']


def trunk_layer(x, mem_k, mem_v, k_past, v_past, shift_prev, wkv0, lw, table):
    B, T = x.shape[0], x.shape[1]
    z = rmsnorm(x, lw['norm_mix_g']) @ lw['w_in']
    q, k, v, zr = jnp.split(z, (ATTN_WIDTH, ATTN_WIDTH + KV_WIDTH, ATTN_WIDTH + 2 * KV_WIDTH), axis=-1)
    q = q.reshape(B, T, ATTN_HEADS, ATTN_HEAD_DIM)
    k = k.reshape(B, T, ATTN_KV_HEADS, ATTN_HEAD_DIM)
    v = v.reshape(B, T, ATTN_KV_HEADS, ATTN_HEAD_DIM)
    a_out, k_buf, v_buf = window_attention(q, k, v, k_past, v_past, lw['attn_sink'], table)
    r_out, shift_new, S = rwkv7_mixer(zr, shift_prev, wkv0, lw)
    x = x + jnp.concatenate([a_out, r_out], axis=-1) @ lw['w_out']
    x = x + memory_cross_attention(rmsnorm(x, lw['norm_cross_g']), mem_k, mem_v, lw)
    hm = rmsnorm(x, lw['norm_mlp_g'])
    x = x + jnp.square(jax.nn.relu(hm @ lw['w_up'])) @ lw['w_down']
    return x, k_buf, v_buf, shift_new, S


def setup_inputs(seed: int = 0) -> dict:
    key = jax.random.key(seed)
    ks = iter(jax.random.split(key, 48))
    f32 = jnp.float32

    def nrm(shape, scale):
        return scale * jax.random.normal(next(ks), shape, f32)

    def unif(shape, lo, hi):
        return jax.random.uniform(next(ks), shape, f32, minval=lo, maxval=hi)

    L = DEPTH
    return {
        'x_prompt': nrm((BATCH, SEQ, D_MODEL), 1.0),
        'x_sample': nrm((DEC_BATCH, DEC_SEQ, D_MODEL), 1.0),
        'mem_prompt': nrm((BATCH, N_MEM, D_MODEL), 1.0),
        'cache_attn_k': nrm((L, DEC_BATCH, WINDOW, ATTN_KV_HEADS, ATTN_HEAD_DIM), 1.0),
        'cache_attn_v': nrm((L, DEC_BATCH, WINDOW, ATTN_KV_HEADS, ATTN_HEAD_DIM), 1.0),
        'cache_mem_k': nrm((L, DEC_BATCH, N_MEM, MEM_HEADS, MEM_HEAD_DIM), 1.0),
        'cache_mem_v': nrm((L, DEC_BATCH, N_MEM, MEM_HEADS, MEM_HEAD_DIM), 1.0),
        'state_shift': nrm((L, DEC_BATCH, 1, RWKV_PROJ), 1.0),
        'state_wkv': nrm((L, DEC_BATCH, RWKV_HEADS, RWKV_HEAD_DIM, RWKV_HEAD_DIM), 0.3),
        'norm_mix_g': 1.0 + nrm((L, D_MODEL), 0.02),
        'w_in': nrm((L, D_MODEL, IN_PROJ), D_MODEL ** -0.5),
        'attn_sink': nrm((L, ATTN_HEADS), 1.0),
        'rel_bias_table': nrm((REL_BUCKETS, ATTN_HEADS), 0.5),
        'rwkv_mu': unif((L, RWKV_PROJ), 0.0, 1.0),
        'rwkv_w0': unif((L, RWKV_WIDTH), -6.0, -0.5),
        'rwkv_w2': nrm((L, DECAY_LORA, RWKV_WIDTH), 0.1 * DECAY_LORA ** -0.5),
        'rwkv_a0': nrm((L, RWKV_WIDTH), 0.5),
        'rwkv_a2': nrm((L, AAA_LORA, RWKV_WIDTH), 0.1 * AAA_LORA ** -0.5),
        'rwkv_g2': nrm((L, GATE_LORA, RWKV_WIDTH), GATE_LORA ** -0.5),
        'rwkv_k_k': 0.85 + nrm((L, RWKV_WIDTH), 0.05),
        'rwkv_k_a': 1.0 + nrm((L, RWKV_WIDTH), 0.05),
        'rwkv_r_k': nrm((L, RWKV_HEADS, RWKV_HEAD_DIM), 0.1),
        'rwkv_ln_w': 1.0 + nrm((L, RWKV_WIDTH), 0.02),
        'rwkv_ln_b': nrm((L, RWKV_WIDTH), 0.02),
        'w_out': nrm((L, MIX_WIDTH, D_MODEL), MIX_WIDTH ** -0.5),
        'norm_cross_g': 1.0 + nrm((L, D_MODEL), 0.02),
        'norm_mem_g': 1.0 + nrm((L, D_MODEL), 0.02),
        'w_cq': nrm((L, D_MODEL, MEM_WIDTH), D_MODEL ** -0.5),
        'w_mk': nrm((L, D_MODEL, MEM_WIDTH), D_MODEL ** -0.5),
        'w_mv': nrm((L, D_MODEL, MEM_WIDTH), D_MODEL ** -0.5),
        'w_co': nrm((L, MEM_WIDTH, D_MODEL), MEM_WIDTH ** -0.5),
        'norm_mlp_g': 1.0 + nrm((L, D_MODEL), 0.02),
        'w_up': nrm((L, D_MODEL, D_FF), D_MODEL ** -0.5),
        'w_down': nrm((L, D_FF, D_MODEL), D_FF ** -0.5),
        'norm_final_g': 1.0 + nrm((D_MODEL,), 0.02),
    }


def reference(x_prompt, x_sample, mem_prompt, cache_attn_k, cache_attn_v, cache_mem_k, cache_mem_v,
              state_shift, state_wkv, norm_mix_g, w_in, attn_sink, rel_bias_table, rwkv_mu, rwkv_w0,
              rwkv_w2, rwkv_a0, rwkv_a2, rwkv_g2, rwkv_k_k, rwkv_k_a, rwkv_r_k, rwkv_ln_w, rwkv_ln_b,
              w_out, norm_cross_g, norm_mem_g, w_cq, w_mk, w_mv, w_co, norm_mlp_g, w_up, w_down,
              norm_final_g):
    Bp = x_prompt.shape[0]
    xp, xs = x_prompt, x_sample
    p_k, p_v, p_mk, p_mv, p_sh, p_S = [], [], [], [], [], []
    s_k, s_v, s_sh, s_S = [], [], [], []
    for l in range(DEPTH):
        lw = {
            'norm_mix_g': norm_mix_g[l], 'w_in': w_in[l], 'attn_sink': attn_sink[l],
            'rwkv_mu': rwkv_mu[l], 'rwkv_w0': rwkv_w0[l], 'rwkv_w2': rwkv_w2[l],
            'rwkv_a0': rwkv_a0[l], 'rwkv_a2': rwkv_a2[l], 'rwkv_g2': rwkv_g2[l],
            'rwkv_k_k': rwkv_k_k[l], 'rwkv_k_a': rwkv_k_a[l], 'rwkv_r_k': rwkv_r_k[l],
            'rwkv_ln_w': rwkv_ln_w[l], 'rwkv_ln_b': rwkv_ln_b[l], 'w_out': w_out[l],
            'norm_cross_g': norm_cross_g[l], 'norm_mem_g': norm_mem_g[l],
            'w_cq': w_cq[l], 'w_mk': w_mk[l], 'w_mv': w_mv[l], 'w_co': w_co[l],
            'norm_mlp_g': norm_mlp_g[l], 'w_up': w_up[l], 'w_down': w_down[l],
        }
        mk, mv = memory_kv(mem_prompt, lw)
        shift0 = jnp.zeros((Bp, 1, RWKV_PROJ), xp.dtype)
        wkv_zero = jnp.zeros((Bp, RWKV_HEADS, RWKV_HEAD_DIM, RWKV_HEAD_DIM), jnp.float32)
        xp, kb, vb, sh, S = trunk_layer(xp, mk, mv, None, None, shift0, wkv_zero, lw, rel_bias_table)
        p_k.append(kb); p_v.append(vb); p_mk.append(mk); p_mv.append(mv); p_sh.append(sh); p_S.append(S)
        xs, kb2, vb2, sh2, S2 = trunk_layer(xs, cache_mem_k[l], cache_mem_v[l], cache_attn_k[l], cache_attn_v[l],
                                            state_shift[l], state_wkv[l], lw, rel_bias_table)
        s_k.append(kb2); s_v.append(vb2); s_sh.append(sh2); s_S.append(S2)
    y_prompt = rmsnorm(xp, norm_final_g)
    y_sample = rmsnorm(xs, norm_final_g)
    return (y_prompt, y_sample,
            jnp.stack(p_k), jnp.stack(p_v), jnp.stack(p_mk), jnp.stack(p_mv), jnp.stack(p_sh), jnp.stack(p_S),
            jnp.stack(s_k), jnp.stack(s_v), jnp.stack(s_sh), jnp.stack(s_S))
```

```cpp
#define MK_SPLIT 0
#include <hip/hip_runtime.h>
#include <cstdio>
#include <cstdint>
namespace pg8 {
#define PG8_LAS __attribute__((address_space(3)))
typedef unsigned short bf16_t;
typedef short bf16x8 __attribute__((ext_vector_type(8)));
typedef float f32x4 __attribute__((ext_vector_type(4)));
typedef unsigned u32x4 __attribute__((ext_vector_type(4)));
constexpr int BM = 256, BK = 64, HALF = 128, HTB = HALF * BK * 2  , STAGE_BYTES = 8 * HTB, NXCD = 8, WGM = 8;

__host__ __device__ __forceinline__ int lds_byte(int r, int c) { const int st = (r >> 4) * 2 + (c >> 5), rr = r & 15, cc = c & 31, ob = rr * 64 + cc * 2; return st * 1024 + (ob ^ (((ob >> 9) & 1) << 5)); }
__host__ __device__ __forceinline__ void stage_rc(int b, int& R, int& C) { const int st = b / 1024, sb = b % 1024, swz = sb ^ (((sb >> 9) & 1) << 5); R = (st >> 1) * 16 + swz / 64; C = (st & 1) * 32 + (swz % 64) / 2; }
__host__ __device__ __forceinline__ int perm32(int rho) { const int n = rho >> 4, i = rho & 15; return 8 * (i >> 2) + 4 * n + (i & 3); }

struct Unit { int pm, pn; };
struct Gemm { const bf16_t* A; const bf16_t* Bt; int M, N, K; };

struct StaticOrder {
    int nM, nN, nwg, G, c;
    __host__ __device__ void init(int M, int N, int G_, int c_) { nM = M / BM; nN = N / BM; nwg = nM * nN; G = G_; c = c_; }
    __host__ __device__ bool next(int i, Unit& u) const {
        const long L = (long)i * G + c; if (L >= nwg) return false;
        int wgid = (int)L; { const int q = nwg / NXCD, r = nwg % NXCD, xcd = wgid % NXCD, off = wgid / NXCD; wgid = (xcd < r ? xcd * (q + 1) : r * (q + 1) + (xcd - r) * q) + off; }
        const int nig = WGM * nN, gid = wgid / nig, fm = gid * WGM, gsz = (nM - fm) < WGM ? (nM - fm) : WGM;
        u.pm = fm + ((wgid % nig) % gsz); u.pn = (wgid % nig) / gsz; return true;
    }
    __device__ __forceinline__ void a_ready(const Unit&) const {}
    __device__ __forceinline__ void done(const Unit&) const {}
};

__device__ __forceinline__ unsigned cvt_pk_bf16(float lo, float hi) { unsigned r; asm volatile("v_cvt_pk_bf16_f32 %0, %1, %2" : "=v"(r) : "v"(lo), "v"(hi)); return r; }
template <class Epi, class Sched, bool ALIGN_EPI = false, bool SP2 = false>
__device__ __forceinline__ void gemm_phase(PG8_LAS unsigned char* lds, const Gemm g, const Sched& S, const Epi& E) {
    const int tid = threadIdx.x, wid = __builtin_amdgcn_readfirstlane(tid >> 6), lane = tid & 63, wr = wid >> 2, wc = wid & 3, fr = lane & 15, fq = lane >> 4;
    const int K = g.K, nt = K / BK;
    unsigned voffA[2], voffB[2];
#pragma unroll
    for (int i = 0; i < 2; ++i) { int R, C; stage_rc(tid * 16 + i * 8192, R, C); const int Rb = Epi::PERM ? ((R & ~31) + perm32(R & 31)) : R;
        voffA[i] = (unsigned)(R * K + C) * 2u; voffB[i] = (unsigned)(Rb * K + C) * 2u; }
    const size_t kstep = (size_t)(BK * 2);
    const size_t hstep = (size_t)HALF * K * 2;
    const size_t tstep = 2 * hstep;
    const unsigned ldsw = (unsigned)wid * 1024u;
    const int aoff = lds_byte(wr * 64 + fr, fq * 8), boff = lds_byte(wc * 32 + fr, fq * 8);
#define PG8_SA(b, h) (((b) * 2 + (h)) * HTB)
#define PG8_SB(b, h) ((4 + (b) * 2 + (h)) * HTB)
#define PG8_STAGE(bufoff, gbase, voff) do { _Pragma("unroll") for (int _i = 0; _i < 2; ++_i) \
        __builtin_amdgcn_global_load_lds((const unsigned*)((const char*)(gbase) + (voff)[_i]), (PG8_LAS unsigned*)(lds + (bufoff) + ldsw + _i * 8192), 16, 0, 0); } while (0)
#define PG8_LDA(dst, b, h) do { _Pragma("unroll") for (int m = 0; m < 4; ++m) _Pragma("unroll") for (int k = 0; k < 2; ++k) dst[m][k] = *(const PG8_LAS bf16x8*)(lds + PG8_SA(b, h) + aoff + m * 2048 + k * 1024); } while (0)
#define PG8_LDB(dst, b, h) do { _Pragma("unroll") for (int n = 0; n < 2; ++n) _Pragma("unroll") for (int k = 0; k < 2; ++k) dst[n][k] = *(const PG8_LAS bf16x8*)(lds + PG8_SB(b, h) + boff + n * 2048 + k * 1024); } while (0)
#define PG8_MMA(ai, bj, At, Bt) do { __builtin_amdgcn_s_setprio(1); _Pragma("unroll") for (int m = 0; m < 4; ++m) _Pragma("unroll") for (int n = 0; n < 2; ++n) _Pragma("unroll") for (int k = 0; k < 2; ++k) \
        acc[ai][bj][m][n] = __builtin_amdgcn_mfma_f32_16x16x32_bf16(Bt[n][k], At[m][k], acc[ai][bj][m][n], 0, 0, 0); __builtin_amdgcn_s_setprio(0); } while (0)
#define PG8_WAIT_V(n) asm volatile("s_waitcnt vmcnt(" #n ")" ::: "memory")
#define PG8_WAIT_L(n) asm volatile("s_waitcnt lgkmcnt(" #n ")" ::: "memory")
#define PG8_BAR __builtin_amdgcn_s_barrier()
#define PG8_SCHED __builtin_amdgcn_sched_barrier(0)
    Unit cur, nxt; int ui = 0;
    if (!S.next(0, cur)) return;
    f32x4 acc[2][2][4][2];
#pragma unroll
    for (int a = 0; a < 2; ++a)
#pragma unroll
        for (int b = 0; b < 2; ++b)
#pragma unroll
            for (int m = 0; m < 4; ++m)
#pragma unroll
                for (int n = 0; n < 2; ++n) acc[a][b][m][n] = (f32x4){0.f, 0.f, 0.f, 0.f};
    bf16x8 At[4][2], B0[2][2], B1[2][2];
    const char* cA = (const char*)g.A + (size_t)cur.pm * tstep; const char* cB = (const char*)g.Bt + (size_t)cur.pn * tstep;
    S.a_ready(cur);
    if constexpr (SP2) {
        PG8_STAGE(PG8_SB(0, 0), cB, voffB); PG8_STAGE(PG8_SB(0, 1), cB + hstep, voffB); PG8_STAGE(PG8_SA(0, 0), cA, voffA); PG8_STAGE(PG8_SA(0, 1), cA + hstep, voffA);
        if (wr == 1) PG8_BAR;
        PG8_WAIT_V(2); PG8_BAR;
        PG8_STAGE(PG8_SB(1, 0), cB + kstep, voffB); PG8_STAGE(PG8_SA(1, 0), cA + kstep, voffA); PG8_STAGE(PG8_SB(1, 1), cB + hstep + kstep, voffB);
        PG8_WAIT_V(6); PG8_BAR;
    } else {
        PG8_STAGE(PG8_SB(0, 0), cB, voffB); PG8_STAGE(PG8_SA(0, 0), cA, voffA); PG8_STAGE(PG8_SB(0, 1), cB + hstep, voffB); PG8_STAGE(PG8_SA(0, 1), cA + hstep, voffA);
        if (wr == 1) PG8_BAR;
        PG8_WAIT_V(4); PG8_BAR;
        PG8_STAGE(PG8_SB(1, 0), cB + kstep, voffB); PG8_STAGE(PG8_SA(1, 0), cA + kstep, voffA); PG8_STAGE(PG8_SB(1, 1), cB + hstep + kstep, voffB);
        PG8_WAIT_V(6); PG8_BAR;
    }
    for (;;) {
        const bool has_next = S.next(ui + 1, nxt);
        const char* nA = has_next ? (const char*)g.A + (size_t)nxt.pm * tstep : cA; const char* nB = has_next ? (const char*)g.Bt + (size_t)nxt.pn * tstep : cB;
        for (int t = 0; t < nt; t += 2) {
            const bool last = (t == nt - 2);
            const char* a1 = cA + (size_t)(t + 1) * kstep;
            const char* a2 = last ? nA : cA + (size_t)(t + 2) * kstep; const char* b2 = last ? nB : cB + (size_t)(t + 2) * kstep;
            const char* a3 = a2 + kstep; const char* b3 = b2 + kstep;
            if (last && has_next) S.a_ready(nxt);
            if constexpr (SP2) {
            PG8_LDB(B0, 0, 0); PG8_LDB(B1, 0, 1); PG8_SCHED; PG8_LDA(At, 0, 0); PG8_STAGE(PG8_SA(1, 1), a1 + hstep, voffA);
            PG8_WAIT_V(8); PG8_WAIT_L(0); PG8_BAR; PG8_MMA(0, 0, At, B0); PG8_MMA(0, 1, At, B1); PG8_BAR; PG8_SCHED;
            PG8_LDA(At, 0, 1); PG8_STAGE(PG8_SB(0, 0), b2, voffB); PG8_STAGE(PG8_SB(0, 1), b2 + hstep, voffB); PG8_STAGE(PG8_SA(0, 0), a2, voffA);
            PG8_WAIT_V(8); PG8_WAIT_L(0); PG8_BAR; PG8_MMA(1, 0, At, B0); PG8_MMA(1, 1, At, B1); PG8_BAR; PG8_SCHED;
            PG8_LDB(B0, 1, 0); PG8_LDB(B1, 1, 1); PG8_SCHED; PG8_LDA(At, 1, 0); PG8_STAGE(PG8_SA(0, 1), a2 + hstep, voffA);
            PG8_WAIT_V(8); PG8_WAIT_L(0); PG8_BAR; PG8_MMA(0, 0, At, B0); PG8_MMA(0, 1, At, B1); PG8_BAR; PG8_SCHED;
            PG8_LDA(At, 1, 1); PG8_STAGE(PG8_SB(1, 0), b3, voffB); PG8_STAGE(PG8_SB(1, 1), b3 + hstep, voffB); PG8_STAGE(PG8_SA(1, 0), a3, voffA);
            PG8_WAIT_V(8); PG8_WAIT_L(0); PG8_BAR; PG8_MMA(1, 0, At, B0); PG8_MMA(1, 1, At, B1); PG8_BAR; PG8_SCHED;
            } else {
            PG8_LDB(B0, 0, 0); PG8_SCHED; PG8_LDA(At, 0, 0); PG8_STAGE(PG8_SA(1, 1), a1 + hstep, voffA);
            PG8_WAIT_L(8); PG8_BAR; PG8_WAIT_L(0); PG8_MMA(0, 0, At, B0); PG8_BAR; PG8_SCHED;
            PG8_LDB(B1, 0, 1); PG8_STAGE(PG8_SB(0, 0), b2, voffB);
            PG8_BAR; PG8_WAIT_L(0); PG8_MMA(0, 1, At, B1); PG8_BAR;
            PG8_LDA(At, 0, 1); PG8_STAGE(PG8_SA(0, 0), a2, voffA);
            PG8_BAR; PG8_WAIT_L(0); PG8_MMA(1, 0, At, B0); PG8_BAR; PG8_SCHED;
            PG8_STAGE(PG8_SB(0, 1), b2 + hstep, voffB);
            PG8_WAIT_V(6); PG8_BAR; PG8_MMA(1, 1, At, B1); PG8_BAR;
            PG8_LDB(B0, 1, 0); PG8_SCHED; PG8_LDA(At, 1, 0); PG8_STAGE(PG8_SA(0, 1), a2 + hstep, voffA);
            PG8_WAIT_L(8); PG8_BAR; PG8_WAIT_L(0); PG8_MMA(0, 0, At, B0); PG8_BAR; PG8_SCHED;
            PG8_LDB(B1, 1, 1); PG8_STAGE(PG8_SB(1, 0), b3, voffB);
            PG8_BAR; PG8_WAIT_L(0); PG8_MMA(0, 1, At, B1); PG8_BAR;
            PG8_LDA(At, 1, 1); PG8_STAGE(PG8_SA(1, 0), a3, voffA);
            PG8_BAR; PG8_WAIT_L(0); PG8_MMA(1, 0, At, B0); PG8_BAR; PG8_SCHED;
            PG8_STAGE(PG8_SB(1, 1), b3 + hstep, voffB);
            PG8_WAIT_V(6); PG8_BAR; PG8_MMA(1, 1, At, B1); PG8_BAR;
            }
        }
        if constexpr (ALIGN_EPI) { if (wr == 0) PG8_BAR; }
        if constexpr (!Epi::AFTER_DRAIN) { E(acc, cur, wr, wc, fr, fq); S.done(cur); }
        if (!has_next) break;
#pragma unroll
        for (int a = 0; a < 2; ++a)
#pragma unroll
            for (int b = 0; b < 2; ++b)
#pragma unroll
                for (int m = 0; m < 4; ++m)
#pragma unroll
                    for (int n = 0; n < 2; ++n) acc[a][b][m][n] = (f32x4){0.f, 0.f, 0.f, 0.f};
        cur = nxt; cA = nA; cB = nB; ++ui;
        if constexpr (ALIGN_EPI) { if (wr == 1) PG8_BAR; }
    }
    PG8_WAIT_V(0);
    if constexpr (!ALIGN_EPI) { if (wr == 0) PG8_BAR; }
    PG8_BAR;
    if constexpr (Epi::AFTER_DRAIN) { E.fused(acc, cur, wr, wc, fr, fq, lds, wid, lane); S.done(cur); }
#undef PG8_SA
#undef PG8_SB
#undef PG8_STAGE
#undef PG8_LDA
#undef PG8_LDB
#undef PG8_MMA
#undef PG8_WAIT_V
#undef PG8_WAIT_L
#undef PG8_BAR
#undef PG8_SCHED
}
}
#define GAS __attribute__((address_space(1)))
#define LAS __attribute__((address_space(3)))
typedef unsigned short bf16;
typedef unsigned v4u __attribute__((ext_vector_type(4)));
typedef float f32x4 __attribute__((ext_vector_type(4)));
typedef short bf16x8 __attribute__((ext_vector_type(8)));
typedef GAS unsigned gu32;
typedef GAS unsigned long long gu64;
#define RLX_AGENT __ATOMIC_RELAXED, __HIP_MEMORY_SCOPE_AGENT
#define LDS_WAIT() asm volatile("s_waitcnt lgkmcnt(0)" ::: "memory")
#define VM_WAIT() asm volatile("s_waitcnt vmcnt(0)" ::: "memory")
__device__ __forceinline__ unsigned long long rt() { return __builtin_amdgcn_s_memrealtime(); }
__device__ __forceinline__ unsigned f2bf(float f) { unsigned u = __builtin_bit_cast(unsigned, f); return (u + 0x7fffu + ((u >> 16) & 1u)) >> 16; }
__device__ __forceinline__ unsigned pk2(float lo, float hi) { return f2bf(lo) | (f2bf(hi) << 16); }
#define XB_TMO      128
#define XB_XCNT(j)  (256  + 64 * (j))
#define XB_XSUB(j)  (1280 + 64 * (j))
#define XB_XGEN(j)  (2304 + 64 * (j))
#define XB_TOP      3328
#define XB_TOPGEN   3392
#define XCD_BAR_WORDS 3456
#define XB_SPIN_CAP (1u << 18)

__device__ __forceinline__ unsigned xb_ld(unsigned* p)              { return __hip_atomic_load(p, __ATOMIC_RELAXED, __HIP_MEMORY_SCOPE_AGENT); }
__device__ __forceinline__ unsigned xb_add(unsigned* p, unsigned v) { return __hip_atomic_fetch_add(p, v, __ATOMIC_RELAXED, __HIP_MEMORY_SCOPE_AGENT); }
__device__ __forceinline__ unsigned xb_xcc_id() { return (unsigned)__builtin_amdgcn_s_getreg((3 << 11) | 20) & 0xFu; }
#define XB_SPIN(cond, bar) do { unsigned _sp = 0; while (cond) { __builtin_amdgcn_s_sleep(1); \
    if ((++_sp & 255u) == 0u) { if (xb_ld(&(bar)[XB_TMO])) break; if (_sp > XB_SPIN_CAP) { atomicAdd(&(bar)[XB_TMO], 1u); break; } } } } while (0)

struct XcdBarrier {
    unsigned* bar; unsigned x;
    volatile LAS unsigned* st;
};

__device__ __forceinline__ XcdBarrier xcd_barrier_post(unsigned* bar, volatile LAS unsigned* st) {
    XcdBarrier b; b.bar = bar; b.x = xb_xcc_id(); b.st = st;
    if (threadIdx.x == 0) (void)xb_add(&bar[XB_XCNT(b.x)], 1u);
    return b;
}
__device__ __forceinline__ void xcd_barrier_complete(unsigned* bar, unsigned x, unsigned& nloc, unsigned& nx) {
    const unsigned G = gridDim.x * gridDim.y * gridDim.z;
    unsigned sum, cnt, mine, sp = 0u;
    for (;;) {
        sum = 0u; cnt = 0u; mine = 0u;
#pragma unroll
        for (unsigned j = 0; j < 16; ++j) { const unsigned c = xb_ld(&bar[XB_XCNT(j)]); sum += c; cnt += (c > 0u) ? 1u : 0u; mine = (j == x) ? c : mine; }
        if (sum == G) break;
        __builtin_amdgcn_s_sleep(1);
        if ((++sp & 255u) == 0u) { if (xb_ld(&bar[XB_TMO])) break; if (sp > XB_SPIN_CAP) { atomicAdd(&bar[XB_TMO], 1u); break; } }
    }
    nloc = mine > 0u ? mine : 1u; nx = cnt > 0u ? cnt : 1u;
}

__device__ __forceinline__ void xcd_barrier(const XcdBarrier& b) {
    asm volatile("s_waitcnt vmcnt(0)" ::: "memory");
    __syncthreads();
    if (threadIdx.x == 0) {
        unsigned* bar = b.bar;
        __builtin_amdgcn_s_waitcnt(0);
        unsigned nloc = b.st[0], nx = b.st[1];
        if (nloc == 0u) { xcd_barrier_complete(bar, b.x, nloc, nx); b.st[0] = nloc; b.st[1] = nx; }
        const unsigned old = xb_add(&bar[XB_XSUB(b.x)], 1u);
        const unsigned gen = old / nloc;
        if (old + 1u == (gen + 1u) * nloc) {
            __builtin_amdgcn_fence(__ATOMIC_RELEASE, "agent");
            asm volatile("s_waitcnt vmcnt(0)" ::: "memory");
            const unsigned og = xb_add(&bar[XB_TOP], 1u);
            const unsigned tg = og / nx;
            if (og + 1u == (tg + 1u) * nx) xb_add(&bar[XB_TOPGEN], 1u);
            else XB_SPIN(xb_ld(&bar[XB_TOPGEN]) == tg, bar);
            __builtin_amdgcn_fence(__ATOMIC_ACQUIRE, "agent");
            xb_add(&bar[XB_XGEN(b.x)], 1u);
            asm volatile("s_waitcnt vmcnt(0)" ::: "memory");
        } else {
            XB_SPIN(xb_ld(&bar[XB_XGEN(b.x)]) == gen, bar);
            __builtin_amdgcn_fence(__ATOMIC_ACQUIRE, "agent");
            asm volatile("s_waitcnt vmcnt(0)" ::: "memory");
        }
    }
    __syncthreads();
}

constexpr int NWAVES = 8, NTHR = 512;
constexpr int DM = 1024, MP = 16384, MS = 256, MALL = 16640;
constexpr int NQKV = 768, NZR = 1792, RW = 512, DFF = 4096, MEMW = 512;
constexpr float LOG2E = 1.4426950408889634f;
constexpr float NORM_EPS = 1e-6f, GN_EPS = 64e-5f;

constexpr size_t OFF_Y = 0, OFF_PK = 17039360, OFF_PV = 17104896, OFF_PMK = 17170432, OFF_PMV = 17694720, OFF_PSH = 18219008, OFF_PWKV = 18226176,
                 OFF_SK = 18357248, OFF_SV = 18488320, OFF_SSH = 18619392, OFF_SWKV = 18633728, OUT_TOTAL = 18895872;
constexpr size_t KiB = 1024, MiB = 1u << 20;
constexpr size_t WS_CTL = 0, CTL_ZERO_BYTES = 64 * KiB;
constexpr size_t WS_WIN = 1 * MiB, WS_WOUT = 6 * MiB, WS_WCQ = 8 * MiB, WS_WCO = 9 * MiB, WS_WUP = 10 * MiB, WS_WDN = 18 * MiB, WS_WMKV = 26 * MiB, WS_WLORA = 28 * MiB;
constexpr size_t PART_BYTES = 1114112;
constexpr size_t WS_PART1 = 28 * MiB + 768 * KiB, WS_PART2 = WS_PART1 + PART_BYTES, WS_PART3 = WS_PART2 + PART_BYTES;
constexpr size_t WS_XN = 32 * MiB;
constexpr size_t WS_MN = 64 * MiB + 512 * KiB;
constexpr size_t WS_MKB = 66 * MiB + 512 * KiB, WS_MVB = 69 * MiB + 512 * KiB;
constexpr size_t WS_QKV = 73 * MiB;
constexpr size_t WS_RKV = 97 * MiB + 512 * KiB;
constexpr size_t WS_ZR = 146 * MiB + 256 * KiB;
constexpr size_t WS_LW = WS_ZR, WS_G = 178 * MiB + 768 * KiB;
constexpr size_t WS_AP = 203 * MiB + 256 * KiB;
constexpr size_t WS_AH = 211 * MiB + 512 * KiB;
constexpr size_t WS_XB = 211 * MiB + 512 * KiB;
constexpr size_t WS_H = 73 * MiB;
constexpr size_t WS_BON = WS_PART3;
constexpr size_t WS_END = 244 * MiB;
static_assert(WS_PART3 + PART_BYTES <= WS_XN && WS_XN + (size_t)MALL * DM * 2 <= WS_MN && WS_MVB + 3 * MiB <= WS_QKV, "ws map 1");
static_assert(WS_QKV + (size_t)MALL * NQKV * 2 <= WS_RKV && WS_RKV + (size_t)MALL * 1536 * 2 <= WS_ZR && WS_ZR + (size_t)MALL * NZR * 2 <= WS_AP, "ws map 2");
static_assert(WS_LW + (size_t)MALL * 512 * 4 <= WS_G && WS_G + (size_t)MALL * 512 * 2 <= WS_AP && WS_AP + (size_t)MALL * 256 * 2 <= WS_AH, "ws map 3");
static_assert(WS_XB + (size_t)MALL * DM * 2 <= WS_END && WS_H + (size_t)MALL * DFF * 2 <= WS_AP, "ws map 4");
constexpr int CW_BAR = 4096;

constexpr int RING_BYTES = 131072, LDSCTL_OFF = RING_BYTES, MISC_OFF = LDSCTL_OFF + 320, LDS_BYTES = 147456;

typedef float f32x16 __attribute__((ext_vector_type(16)));
typedef short bf16x4 __attribute__((ext_vector_type(4)));
typedef unsigned u32x2 __attribute__((ext_vector_type(2)));

__device__ __forceinline__ float bf2f(unsigned short b) { return __uint_as_float((unsigned)b << 16); }
__device__ __forceinline__ float wave_sum(float v) {
#pragma unroll
    for (int o = 1; o < 64; o <<= 1) v += __shfl_xor(v, o);
    return v;
}
__device__ __forceinline__ float sigmoidf_(float x) { return 1.0f / (1.0f + __expf(-x)); }

struct Frame {
    LAS unsigned char* lds; volatile LAS unsigned* MISC; gu32* ctl;
    int tid, lane, wave, vcu, G;
    const float* const* in; float* out; unsigned char* ws;
};

__device__ __forceinline__ void p0_transpose_item(const float* W, int K, int N, bf16* WT, int row_off, const float* gk, LAS float* scr, int item, int lane) {
    const int nblk = N / 32, kb = item / nblk, nb = item % nblk, k0 = 64 * kb, n0 = 32 * nb;
#pragma unroll 8
    for (int i = 0; i < 32; ++i) { const int kk = 2 * i + (lane >> 5); float v = W[(size_t)(k0 + kk) * N + n0 + (lane & 31)]; if (gk) v *= gk[k0 + kk]; scr[kk * 33 + (lane & 31)] = v; }
    LDS_WAIT(); asm volatile("" ::: "memory");
    const int c = lane & 7;
#pragma unroll
    for (int j = 0; j < 4; ++j) { const int n = (lane >> 3) + 8 * j; const LAS float* s = scr + (8 * c) * 33 + n;
        v4u o; o.x = pk2(s[0 * 33], s[1 * 33]); o.y = pk2(s[2 * 33], s[3 * 33]); o.z = pk2(s[4 * 33], s[5 * 33]); o.w = pk2(s[6 * 33], s[7 * 33]);
        *(GAS v4u*)(WT + (size_t)(row_off + n0 + n) * K + k0 + 8 * c) = o; }
    LDS_WAIT(); asm volatile("" ::: "memory");
}
__device__ __forceinline__ void rms_row_to_bf16(const float* xrow, const float* g, bf16* orow, int lane) {
    const GAS f32x4* xr = (const GAS f32x4*)xrow + lane; const GAS f32x4* gr = (const GAS f32x4*)g + lane;
    f32x4 v[4]; float s = 0.f;
#pragma unroll
    for (int j = 0; j < 4; ++j) { v[j] = xr[64 * j]; s += (v[j].x * v[j].x + v[j].y * v[j].y) + (v[j].z * v[j].z + v[j].w * v[j].w); }
    const float rstd = 1.0f / sqrtf(wave_sum(s) * (1.f / 1024.f) + NORM_EPS);
    GAS unsigned long long* o8 = (GAS unsigned long long*)orow + lane;
#pragma unroll
    for (int j = 0; j < 4; ++j) { const f32x4 gg = gr[64 * j];
        o8[64 * j] = (unsigned long long)pk2(v[j].x * rstd * gg.x, v[j].y * rstd * gg.y) | ((unsigned long long)pk2(v[j].z * rstd * gg.z, v[j].w * rstd * gg.w) << 32); }
}
__device__ __forceinline__ void p0_prologue(Frame& F) {
    LAS float* scr = (LAS float*)(F.lds + F.wave * 16384);
    const int gw = F.vcu * NWAVES + F.wave, NGW = F.G * NWAVES;
    unsigned char* ws = F.ws;
    constexpr int I_IN = 16 * 80, I_OUT = 16 * 32, I_CQ = 16 * 16, I_MK = 16 * 16, I_MV = 16 * 16, I_CO = 8 * 32, I_UP = 16 * 128, I_DN = 64 * 32;
    constexpr int NITEMS = I_IN + I_OUT + I_CQ + I_MK + I_MV + I_CO + I_UP + I_DN;
    for (int it = gw; it < NITEMS; it += NGW) {
        int r = it;
        if (r < I_IN) { p0_transpose_item(F.in[10], 1024, 2560, (bf16*)(ws + WS_WIN), 0, nullptr, scr, r, F.lane); continue; } r -= I_IN;
        if (r < I_OUT) { p0_transpose_item(F.in[24], 1024, 1024, (bf16*)(ws + WS_WOUT), 0, nullptr, scr, r, F.lane); continue; } r -= I_OUT;
        if (r < I_CQ) { p0_transpose_item(F.in[27], 1024, 512, (bf16*)(ws + WS_WCQ), 0, F.in[25], scr, r, F.lane); continue; } r -= I_CQ;
        if (r < I_MK) { p0_transpose_item(F.in[28], 1024, 512, (bf16*)(ws + WS_WMKV), 0, nullptr, scr, r, F.lane); continue; } r -= I_MK;
        if (r < I_MV) { p0_transpose_item(F.in[29], 1024, 512, (bf16*)(ws + WS_WMKV), 512, nullptr, scr, r, F.lane); continue; } r -= I_MV;
        if (r < I_CO) { p0_transpose_item(F.in[30], 512, 1024, (bf16*)(ws + WS_WCO), 0, nullptr, scr, r, F.lane); continue; } r -= I_CO;
        if (r < I_UP) { p0_transpose_item(F.in[32], 1024, 4096, (bf16*)(ws + WS_WUP), 0, F.in[31], scr, r, F.lane); continue; } r -= I_UP;
        p0_transpose_item(F.in[33], 4096, 1024, (bf16*)(ws + WS_WDN), 0, nullptr, scr, r, F.lane);
    }
    {
        bf16* WL = (bf16*)(ws + WS_WLORA); const float* w2 = F.in[15]; const float* a2 = F.in[17]; const float* g2 = F.in[18];
        const int gt = F.vcu * NTHR + F.tid, NGT = F.G * NTHR;
        for (int idx = gt; idx < 1536 * 256; idx += NGT) {
            const int n = idx >> 8, k = idx & 255; float v = 0.f;
            if (n < 512) { if (k < 64) v = w2[k * 512 + n]; }
            else if (n < 1024) { if (k >= 64 && k < 128) v = a2[(k - 64) * 512 + (n - 512)]; }
            else { if (k >= 128) v = g2[(k - 128) * 512 + (n - 1024)]; }
            WL[idx] = (bf16)f2bf(v);
        }
        const f32x4* ck = (const f32x4*)F.in[5]; const f32x4* cv = (const f32x4*)F.in[6];
        u32x2* mk = (u32x2*)((bf16*)(ws + WS_MKB) + 4 * 256 * 512); u32x2* mv = (u32x2*)((bf16*)(ws + WS_MVB) + 4 * 256 * 512);
        for (int idx = gt; idx < 8 * 256 * 512 / 4; idx += NGT) {
            const f32x4 a = ck[idx], b = cv[idx];
            mk[idx] = (u32x2){pk2(a.x, a.y), pk2(a.z, a.w)}; mv[idx] = (u32x2){pk2(b.x, b.y), pk2(b.z, b.w)};
        }
        const f32x4* ak = (const f32x4*)F.in[3]; const f32x4* av = (const f32x4*)F.in[4];
        f32x4* ok = (f32x4*)(F.out + OFF_SK); f32x4* ov = (f32x4*)(F.out + OFF_SV);
        for (int idx = gt; idx < 8 * 96 * 32; idx += NGT) {
            const int b = idx / (96 * 32), rem = idx % (96 * 32);
            ok[b * 128 * 32 + rem] = ak[b * 128 * 32 + 32 * 32 + rem]; ov[b * 128 * 32 + rem] = av[b * 128 * 32 + 32 * 32 + rem];
        }
    }
    for (int m = gw; m < MALL + 1024; m += NGW) {
        if (m < MALL) { const float* xr = m < MP ? F.in[0] + (size_t)m * DM : F.in[1] + (size_t)(m - MP) * DM; rms_row_to_bf16(xr, F.in[9], (bf16*)(ws + WS_XN) + (size_t)m * DM, F.lane); }
        else { const int r = m - MALL; rms_row_to_bf16(F.in[2] + (size_t)r * DM, F.in[26], (bf16*)(ws + WS_MN) + (size_t)r * DM, F.lane); }
    }
}

#define EPI_ROWS_BEGIN const int row0 = u.pm * 256 + wr * 64 + fr; const int colt = u.pn * 256 + wc * 32 + 8 * fq; \
    _Pragma("unroll") for (int ai = 0; ai < 2; ++ai) _Pragma("unroll") for (int m = 0; m < 4; ++m) { const int row = row0 + ai * 128 + m * 16;
#define EPI_ROWS_END }
__device__ __forceinline__ v4u pack8(const f32x4 a, const f32x4 b) { v4u w; w.x = pg8::cvt_pk_bf16(a[0], a[1]); w.y = pg8::cvt_pk_bf16(a[2], a[3]); w.z = pg8::cvt_pk_bf16(b[0], b[1]); w.w = pg8::cvt_pk_bf16(b[2], b[3]); return w; }

struct EpiIn {
    static constexpr bool PERM = true, AFTER_DRAIN = false;
    bf16* QKV; bf16* ZR; float* out;
    __device__ __forceinline__ void operator()(const f32x4 (&acc)[2][2][4][2], const pg8::Unit& u, int wr, int wc, int fr, int fq) const {
        EPI_ROWS_BEGIN
#pragma unroll
            for (int bj = 0; bj < 2; ++bj) { const int col = colt + bj * 128; const f32x4 v0 = acc[ai][bj][m][0], v1 = acc[ai][bj][m][1];
                const v4u w = pack8(v0, v1);
                if (u.pn < 3) *(v4u*)(QKV + (size_t)row * NQKV + col) = w; else *(v4u*)(ZR + (size_t)row * NZR + (col - NQKV)) = w;
                float* dst = nullptr;
                if (u.pn == 2) { const int cc = col - 512, kv = cc >> 7, c7 = cc & 127;
                    if (row < MP) { const int t = row & 4095; if (t >= 3968) dst = out + (kv ? OFF_PV : OFF_PK) + ((size_t)((row >> 12) * 128 + (t - 3968))) * 128 + c7; }
                    else { const int rs = row - MP; dst = out + (kv ? OFF_SV : OFF_SK) + ((size_t)((rs >> 5) * 128 + 96 + (rs & 31))) * 128 + c7; } }
                else if (u.pn >= 3) { const int zc = col - NQKV;
                    if (row < MP) { if ((row & 4095) == 4095) dst = out + OFF_PSH + (size_t)(row >> 12) * NZR + zc; }
                    else { const int rs = row - MP; if ((rs & 31) == 31) dst = out + OFF_SSH + (size_t)(rs >> 5) * NZR + zc; } }
                if (dst) { *(f32x4*)dst = v0; *(f32x4*)(dst + 4) = v1; } }
        EPI_ROWS_END
    }
};
struct EpiMemKV {
    static constexpr bool PERM = true, AFTER_DRAIN = false;
    bf16* MKB; bf16* MVB; float* out;
    __device__ __forceinline__ void operator()(const f32x4 (&acc)[2][2][4][2], const pg8::Unit& u, int wr, int wc, int fr, int fq) const {
        EPI_ROWS_BEGIN
#pragma unroll
            for (int bj = 0; bj < 2; ++bj) { const int col = colt + bj * 128; const f32x4 v0 = acc[ai][bj][m][0], v1 = acc[ai][bj][m][1];
                const int kv = col >> 9, c = col & 511;
                float* dst = out + (kv ? OFF_PMV : OFF_PMK) + (size_t)row * 512 + c; *(f32x4*)dst = v0; *(f32x4*)(dst + 4) = v1;
                *(v4u*)((kv ? MVB : MKB) + (size_t)row * 512 + c) = pack8(v0, v1); }
        EPI_ROWS_END
    }
};
struct EpiLora {
    static constexpr bool PERM = true, AFTER_DRAIN = false;
    float* LW; bf16* AH; bf16* Gg; const float* w0; const float* a0;
    __device__ __forceinline__ void operator()(const f32x4 (&acc)[2][2][4][2], const pg8::Unit& u, int wr, int wc, int fr, int fq) const {
        EPI_ROWS_BEGIN
#pragma unroll
            for (int bj = 0; bj < 2; ++bj) { const int col = colt + bj * 128; f32x4 v0 = acc[ai][bj][m][0], v1 = acc[ai][bj][m][1];
                const int sel = col >> 9, c = col & 511;
                if (sel == 0) { const f32x4 b0 = *(const f32x4*)(w0 + c), b1 = *(const f32x4*)(w0 + c + 4);
#pragma unroll
                    for (int e = 0; e < 4; ++e) { v0[e] = -0.6065306597f * sigmoidf_(v0[e] + b0[e]); v1[e] = -0.6065306597f * sigmoidf_(v1[e] + b1[e]); }
                    float* dst = LW + (size_t)row * 512 + c; *(f32x4*)dst = v0; *(f32x4*)(dst + 4) = v1; }
                else if (sel == 1) { const f32x4 b0 = *(const f32x4*)(a0 + c), b1 = *(const f32x4*)(a0 + c + 4);
#pragma unroll
                    for (int e = 0; e < 4; ++e) { v0[e] = sigmoidf_(v0[e] + b0[e]); v1[e] = sigmoidf_(v1[e] + b1[e]); }
                    *(v4u*)(AH + (size_t)row * 512 + c) = pack8(v0, v1); }
                else *(v4u*)(Gg + (size_t)row * 512 + c) = pack8(v0, v1); }
        EPI_ROWS_END
    }
};
struct EpiRes {
    static constexpr bool PERM = true, AFTER_DRAIN = false;
    const float* resP; const float* resS; float* out; bf16* XB; float* PART;
    __device__ __forceinline__ void operator()(const f32x4 (&acc)[2][2][4][2], const pg8::Unit& u, int wr, int wc, int fr, int fq) const {
        EPI_ROWS_BEGIN
            const float* rp = row < MP ? resP + (size_t)row * DM : resS + (size_t)(row - MP) * DM; float ss = 0.f;
#pragma unroll
            for (int bj = 0; bj < 2; ++bj) { const int col = colt + bj * 128;
                const f32x4 v0 = acc[ai][bj][m][0] + *(const f32x4*)(rp + col), v1 = acc[ai][bj][m][1] + *(const f32x4*)(rp + col + 4);
                float* dst = out + (size_t)row * DM + col; *(f32x4*)dst = v0; *(f32x4*)(dst + 4) = v1;
                if (XB) *(v4u*)(XB + (size_t)row * DM + col) = pack8(v0, v1);
                ss += (v0[0] * v0[0] + v0[1] * v0[1]) + (v0[2] * v0[2] + v0[3] * v0[3]) + (v1[0] * v1[0] + v1[1] * v1[1]) + (v1[2] * v1[2] + v1[3] * v1[3]); }
            ss += __shfl_xor(ss, 16); ss += __shfl_xor(ss, 32);
            if (fq == 0) PART[(size_t)row * 16 + u.pn * 4 + wc] = ss;
        EPI_ROWS_END
    }
};
template <int ACT  > struct EpiNormBf16 {
    static constexpr bool PERM = true, AFTER_DRAIN = false;
    bf16* O; int ldc; const float* PART; float scale;
    __device__ __forceinline__ void operator()(const f32x4 (&acc)[2][2][4][2], const pg8::Unit& u, int wr, int wc, int fr, int fq) const {
        EPI_ROWS_BEGIN
            const f32x4 pp = *(const f32x4*)(PART + (size_t)row * 16 + 4 * fq); float ss = (pp[0] + pp[1]) + (pp[2] + pp[3]);
            ss += __shfl_xor(ss, 16); ss += __shfl_xor(ss, 32);
            const float rs = scale / sqrtf(ss * (1.f / 1024.f) + NORM_EPS);
#pragma unroll
            for (int bj = 0; bj < 2; ++bj) { const int col = colt + bj * 128; f32x4 v0 = acc[ai][bj][m][0] * rs, v1 = acc[ai][bj][m][1] * rs;
                if (ACT == 1) {
#pragma unroll
                    for (int e = 0; e < 4; ++e) { const float a = fmaxf(v0[e], 0.f), b = fmaxf(v1[e], 0.f); v0[e] = a * a; v1[e] = b * b; } }
                *(v4u*)(O + (size_t)row * ldc + col) = pack8(v0, v1); }
        EPI_ROWS_END
    }
};

__device__ __forceinline__ void p2_prep(Frame& F) {
    const int gw = F.vcu * NWAVES + F.wave, NGW = F.G * NWAVES;
    const bf16* ZR = (const bf16*)(F.ws + WS_ZR); bf16* RKV = (bf16*)(F.ws + WS_RKV); bf16* AP = (bf16*)(F.ws + WS_AP);
    const float* mu = F.in[13]; const float* sshift = F.in[7];
    for (int m = gw; m < MALL; m += NGW) {
        const int t = m < MP ? (m & 4095) : ((m - MP) & 31);
        for (int ch = F.lane; ch < NZR / 8; ch += 64) {
            const int col = ch * 8;
            const v4u cu = *(const v4u*)(ZR + (size_t)m * NZR + col);
            float cur[8], prv[8];
#pragma unroll
            for (int e = 0; e < 4; ++e) { cur[2 * e] = __uint_as_float(cu[e] << 16); cur[2 * e + 1] = __uint_as_float(cu[e] & 0xffff0000u); }
            if (t > 0) { const v4u pu = *(const v4u*)(ZR + (size_t)(m - 1) * NZR + col);
#pragma unroll
                for (int e = 0; e < 4; ++e) { prv[2 * e] = __uint_as_float(pu[e] << 16); prv[2 * e + 1] = __uint_as_float(pu[e] & 0xffff0000u); } }
            else if (m >= MP) { const float* sp = sshift + (size_t)((m - MP) >> 5) * NZR + col;
#pragma unroll
                for (int e = 0; e < 8; ++e) prv[e] = sp[e]; }
            else {
#pragma unroll
                for (int e = 0; e < 8; ++e) prv[e] = 0.f; }
            float zs[8];
#pragma unroll
            for (int e = 0; e < 8; ++e) zs[e] = cur[e] + (prv[e] - cur[e]) * mu[col + e];
            if (col >= 1536) {
                if (col < 1600) {
#pragma unroll
                    for (int e = 0; e < 8; ++e) zs[e] = tanhf(zs[e]); }
                else if (col >= 1664) {
#pragma unroll
                    for (int e = 0; e < 8; ++e) zs[e] = sigmoidf_(zs[e]); }
            }
            v4u w; w.x = pk2(zs[0], zs[1]); w.y = pk2(zs[2], zs[3]); w.z = pk2(zs[4], zs[5]); w.w = pk2(zs[6], zs[7]);
            if (col < 1536) *(v4u*)(RKV + (size_t)m * 1536 + col) = w; else *(v4u*)(AP + (size_t)m * 256 + (col - 1536)) = w;
        }
    }
}

constexpr int SC_TT = 32;
constexpr int SC_BUF_FLOATS = 5 * SC_TT * 64 + SC_TT * 32;
__device__ __forceinline__ float allreduce16(float v) {
    v += __int_as_float(__builtin_amdgcn_update_dpp(0, __float_as_int(v), 0xB1, 0xf, 0xf, false));
    v += __int_as_float(__builtin_amdgcn_update_dpp(0, __float_as_int(v), 0x4E, 0xf, 0xf, false));
    v += __int_as_float(__builtin_amdgcn_update_dpp(0, __float_as_int(v), 0x141, 0xf, 0xf, false));
    v += __int_as_float(__builtin_amdgcn_update_dpp(0, __float_as_int(v), 0x140, 0xf, 0xf, false));
    return v;
}
__device__ __forceinline__ void p4_scan_job(Frame& F, int job) {
    const bool prompt = job < 64; const int bh = prompt ? (job >> 1) : ((job - 64) >> 1), half = job & 1;
    const int b = bh >> 3, h = bh & 7, T = prompt ? 4096 : 32; const int m0 = prompt ? b * 4096 : MP + b * 32;
    const bf16* RKV = (const bf16*)(F.ws + WS_RKV); const float* LW = (const float*)(F.ws + WS_LW); const bf16* AH = (const bf16*)(F.ws + WS_AH);
    float* BON = (float*)(F.ws + WS_BON); float* Yraw = F.out;
    LAS float* L = (LAS float*)F.lds;
    const int lane = F.lane, wave = F.wave, hc = h * 64 + lane;
    const float kkw = F.in[19][hc], kaw = F.in[20][hc], rkw = F.in[21][hc];
    const int il = 4 * wave + (lane >> 4), i = 32 * half + il, jq = lane & 15;
    float S0 = 0.f, S1 = 0.f, S2 = 0.f, S3 = 0.f;
    if (!prompt) { const f32x4 s = *(const f32x4*)(F.in[8] + ((size_t)(bh * 64 + i)) * 64 + 4 * jq); S0 = s[0]; S1 = s[1]; S2 = s[2]; S3 = s[3]; }
    const int ntiles = T / SC_TT;
    float gr[4], gk[4], gv[4], gl[4], ga[4];
#define SC_LOAD(tile) do { _Pragma("unroll") for (int q = 0; q < 4; ++q) { const size_t mm = (size_t)(m0 + (tile) * SC_TT + 4 * wave + q); \
        gr[q] = bf2f(RKV[mm * 1536 + hc]); gk[q] = bf2f(RKV[mm * 1536 + 512 + hc]); gv[q] = bf2f(RKV[mm * 1536 + 1024 + hc]); gl[q] = LW[mm * 512 + hc]; ga[q] = bf2f(AH[mm * 512 + hc]); } } while (0)
#define SC_DERIVE(tile, buf) do { LAS float* Lb = L + (buf) * SC_BUF_FLOATS; _Pragma("unroll") for (int q = 0; q < 4; ++q) { const int s = 4 * wave + q; \
        float kk = gk[q] * kkw; const float n2 = wave_sum(kk * kk); kk = kk / fmaxf(sqrtf(n2), 1e-12f); \
        const float kp = gk[q] * (1.0f + (ga[q] - 1.0f) * kaw); const float bon = wave_sum(gr[q] * kp * rkw); \
        Lb[s * 64 + lane] = __expf(gl[q]); Lb[2048 + s * 64 + lane] = -kk; Lb[4096 + s * 64 + lane] = kk * ga[q]; Lb[6144 + s * 64 + lane] = kp; Lb[8192 + s * 64 + lane] = gr[q]; \
        if ((lane >> 5) == half) Lb[10240 + s * 32 + (lane & 31)] = gv[q]; \
        if (half == 0 && lane == 0) BON[(size_t)(m0 + (tile) * SC_TT + s) * 8 + h] = bon; } } while (0)
    SC_LOAD(0); SC_DERIVE(0, 0);
    __syncthreads();
    for (int tile = 0; tile < ntiles; ++tile) {
        const bool more = tile + 1 < ntiles;
        if (more) SC_LOAD(tile + 1);
        const LAS float* Lb = L + (tile & 1) * SC_BUF_FLOATS;
        float* yp = Yraw + (size_t)(m0 + tile * SC_TT) * 512 + h * 64 + i;
#pragma unroll 4
        for (int s = 0; s < SC_TT; ++s) {
            const f32x4 w4 = *(const LAS f32x4*)(Lb + s * 64 + 4 * jq), a4 = *(const LAS f32x4*)(Lb + 2048 + s * 64 + 4 * jq), b4 = *(const LAS f32x4*)(Lb + 4096 + s * 64 + 4 * jq),
                        k4 = *(const LAS f32x4*)(Lb + 6144 + s * 64 + 4 * jq), r4 = *(const LAS f32x4*)(Lb + 8192 + s * 64 + 4 * jq);
            const float v = Lb[10240 + s * 32 + il];
            float p = (S0 * a4[0] + S1 * a4[1]) + (S2 * a4[2] + S3 * a4[3]);
            const float sa = allreduce16(p);
            S0 = S0 * w4[0] + (sa * b4[0] + v * k4[0]); S1 = S1 * w4[1] + (sa * b4[1] + v * k4[1]);
            S2 = S2 * w4[2] + (sa * b4[2] + v * k4[2]); S3 = S3 * w4[3] + (sa * b4[3] + v * k4[3]);
            float y = (S0 * r4[0] + S1 * r4[1]) + (S2 * r4[2] + S3 * r4[3]);
            y = allreduce16(y);
            if (jq == 0) yp[(size_t)s * 512] = y;
        }
        if (more) SC_DERIVE(tile + 1, (tile + 1) & 1);
        __syncthreads();
    }
#undef SC_LOAD
#undef SC_DERIVE
    float* so = F.out + (prompt ? OFF_PWKV : OFF_SWKV) + ((size_t)(bh * 64 + i)) * 64 + 4 * jq;
    *(f32x4*)so = (f32x4){S0, S1, S2, S3};
}
__device__ __forceinline__ void p4b_post(Frame& F) {
    const int gw = F.vcu * NWAVES + F.wave, NGW = F.G * NWAVES;
    const float* Yraw = F.out; const float* BON = (const float*)(F.ws + WS_BON); const bf16* RKV = (const bf16*)(F.ws + WS_RKV); const bf16* Gg = (const bf16*)(F.ws + WS_G);
    bf16* MIX = (bf16*)(F.ws + WS_XN);
    for (int it = gw; it < MALL * 8; it += NGW) {
        const int m = it >> 3, h = it & 7, hc = h * 64 + F.lane;
        const float y = Yraw[(size_t)m * 512 + hc];
        const float mean = wave_sum(y) * (1.f / 64.f); const float d = y - mean; const float var = wave_sum(d * d) * (1.f / 64.f);
        float o = d * (1.0f / sqrtf(var + GN_EPS)) * F.in[22][hc] + F.in[23][hc];
        o += BON[(size_t)m * 8 + h] * bf2f(RKV[(size_t)m * 1536 + 1024 + hc]);
        o *= bf2f(Gg[(size_t)m * 512 + hc]);
        MIX[(size_t)m * DM + 512 + hc] = (bf16)f2bf(o);
    }
}

template <int D, int G, int KSTR, int VSTR, class ScoreFn>
__device__ __forceinline__ void attn_group(const LAS unsigned char* Kl, const LAS unsigned char* Vl, const bf16x8 (&qf)[D / 16], f32x16 (&o)[D / 32], float& mrun, float& lrun, int lane, const ScoreFn& sf) {
    const int kr = lane & 31, hh = lane >> 5;
    f32x16 s[G];
#pragma unroll
    for (int kb = 0; kb < G; ++kb) {
#pragma unroll
        for (int e = 0; e < 16; ++e) s[kb][e] = 0.f;
#pragma unroll
        for (int ks = 0; ks < D / 16; ++ks) { const bf16x8 kf = *(const LAS bf16x8*)(Kl + (kb * 32 + kr) * KSTR + (ks * 16 + hh * 8) * 2);
            s[kb] = __builtin_amdgcn_mfma_f32_32x32x16_bf16(kf, qf[ks], s[kb], 0, 0, 0); }
    }
    float gmax = -INFINITY;
#pragma unroll
    for (int kb = 0; kb < G; ++kb)
#pragma unroll
        for (int e = 0; e < 16; ++e) { const float v = sf(kb, e, s[kb][e]); s[kb][e] = v; gmax = fmaxf(gmax, v); }
    gmax = fmaxf(gmax, __shfl_xor(gmax, 32));
    const float mn = fmaxf(mrun, gmax); const float alpha = __builtin_amdgcn_exp2f(mrun - mn); mrun = mn;
    float ps = 0.f;
#pragma unroll
    for (int kb = 0; kb < G; ++kb)
#pragma unroll
        for (int e = 0; e < 16; ++e) { const float p = __builtin_amdgcn_exp2f(s[kb][e] - mn); s[kb][e] = p; ps += p; }
    ps += __shfl_xor(ps, 32);
    lrun = lrun * alpha + ps;
#pragma unroll
    for (int db = 0; db < D / 32; ++db)
#pragma unroll
        for (int e = 0; e < 16; ++e) o[db][e] *= alpha;
    const int q4 = (lane & 15) >> 2, p4 = lane & 3, g16 = (lane >> 4) & 1;
#pragma unroll
    for (int kb = 0; kb < G; ++kb)
#pragma unroll
        for (int s2 = 0; s2 < 2; ++s2) {
            v4u pw; pw.x = pg8::cvt_pk_bf16(s[kb][8 * s2 + 0], s[kb][8 * s2 + 1]); pw.y = pg8::cvt_pk_bf16(s[kb][8 * s2 + 2], s[kb][8 * s2 + 3]);
            pw.z = pg8::cvt_pk_bf16(s[kb][8 * s2 + 4], s[kb][8 * s2 + 5]); pw.w = pg8::cvt_pk_bf16(s[kb][8 * s2 + 6], s[kb][8 * s2 + 7]);
            const bf16x8 pf = __builtin_bit_cast(bf16x8, pw);
            const int key0 = kb * 32 + 16 * s2 + 4 * hh;
#pragma unroll
            for (int db = 0; db < D / 32; ++db) {
                const LAS unsigned char* va = Vl + (key0 + q4) * VSTR + (32 * db + 16 * g16 + 4 * p4) * 2;
                const bf16x4 v0 = __builtin_amdgcn_ds_read_tr16_b64_v4i16((LAS bf16x4*)va);
                const bf16x4 v1 = __builtin_amdgcn_ds_read_tr16_b64_v4i16((LAS bf16x4*)(va + 8 * VSTR));
                const bf16x8 vf = __builtin_shufflevector(v0, v1, 0, 1, 2, 3, 4, 5, 6, 7);
                o[db] = __builtin_amdgcn_mfma_f32_32x32x16_bf16(vf, pf, o[db], 0, 0, 0);
            }
        }
}
template <int D> __device__ __forceinline__ void attn_store(const f32x16 (&o)[D / 32], float inv, bf16* orow, int lane) {
    const int hh = lane >> 5;
#pragma unroll
    for (int db = 0; db < D / 32; ++db)
#pragma unroll
        for (int rq = 0; rq < 4; ++rq) {
            u32x2 w; w.x = pg8::cvt_pk_bf16(o[db][4 * rq] * inv, o[db][4 * rq + 1] * inv); w.y = pg8::cvt_pk_bf16(o[db][4 * rq + 2] * inv, o[db][4 * rq + 3] * inv);
            *(u32x2*)(orow + 32 * db + 8 * rq + 4 * hh) = w;
        }
}

constexpr int SWA_KSTR = 144, SWA_VSTR = 192;
constexpr int SWA_K_OFF = 0, SWA_V_OFF = 192 * SWA_KSTR  , SWA_LUT_OFF = SWA_V_OFF + 192 * SWA_VSTR  ;
__device__ __forceinline__ int t5_bucket(int rel) {
    const int n = rel < 0 ? -rel : rel;
    int v = n < 8 ? n : (n < 12 ? 8 : (n < 16 ? 9 : (n < 23 ? 10 : (n < 32 ? 11 : (n < 46 ? 12 : (n < 64 ? 13 : (n < 91 ? 14 : 15)))))));
    return (rel > 0 ? 16 : 0) + v;
}
struct SwaScore { const LAS float* lut; int qi; int hh; int jlo, jhi; float sc2;
    __device__ __forceinline__ float operator()(int kb, int e, float raw) const {
        const int j = kb * 32 + (e & 3) + 8 * (e >> 2) + 4 * hh;
        const float v = raw * sc2 + lut[j - qi + 63];
        return (j >= jlo && j < jhi) ? v : -INFINITY; } };
__device__ __forceinline__ void swa_build_lut(Frame& F) {
    LAS float* lut = (LAS float*)(F.lds + SWA_LUT_OFF); const float* table = F.in[12];
    for (int idx = F.tid; idx < 8 * 256; idx += NTHR) { const int h = idx >> 8, x = idx & 255; const int rel = x - 191;
        lut[idx] = x < 255 ? table[t5_bucket(rel) * 8 + h] * LOG2E : 0.f; }
}
__device__ __forceinline__ void swa_unit(Frame& F, int u) {
    const bool prompt = u < 512; int b, c, kvh;
    if (prompt) { b = u >> 7; c = (u >> 1) & 63; kvh = u & 1; } else { b = (u - 512) >> 1; c = 0; kvh = u & 1; }
    const bf16* QKV = (const bf16*)(F.ws + WS_QKV); bf16* MIX = (bf16*)(F.ws + WS_XN);
    LAS unsigned char* Kl = F.lds + SWA_K_OFF; LAS unsigned char* Vl = F.lds + SWA_V_OFF;
    __syncthreads();
    for (int idx = F.tid; idx < 192 * 8; idx += NTHR) {
        const int j = idx >> 3, c8 = idx & 7; v4u kw = (v4u){0u, 0u, 0u, 0u}, vw = (v4u){0u, 0u, 0u, 0u};
        if (prompt) { const int pos = 64 * c - 128 + j;
            if (pos >= 0) { const bf16* src = QKV + (size_t)(b * 4096 + pos) * NQKV + 512 + 64 * kvh + 8 * c8; kw = *(const v4u*)src; vw = *(const v4u*)(src + 128); } }
        else if (j < 128) { const float* sk = F.in[3] + ((size_t)(b * 128 + j)) * 128 + 64 * kvh + 8 * c8; const float* sv = F.in[4] + ((size_t)(b * 128 + j)) * 128 + 64 * kvh + 8 * c8;
            const f32x4 k0 = *(const f32x4*)sk, k1 = *(const f32x4*)(sk + 4), v0 = *(const f32x4*)sv, v1 = *(const f32x4*)(sv + 4);
            kw = (v4u){pk2(k0[0], k0[1]), pk2(k0[2], k0[3]), pk2(k1[0], k1[1]), pk2(k1[2], k1[3])}; vw = (v4u){pk2(v0[0], v0[1]), pk2(v0[2], v0[3]), pk2(v1[0], v1[1]), pk2(v1[2], v1[3])}; }
        else if (j < 160) { const bf16* src = QKV + (size_t)(MP + b * 32 + (j - 128)) * NQKV + 512 + 64 * kvh + 8 * c8; kw = *(const v4u*)src; vw = *(const v4u*)(src + 128); }
        *(LAS v4u*)(Kl + j * SWA_KSTR + c8 * 16) = kw; *(LAS v4u*)(Vl + j * SWA_VSTR + c8 * 16) = vw;
    }
    __syncthreads();
    const int wave = F.wave, lane = F.lane;
    const bool active = prompt || wave < 4;
    if (active) {
        const int head = 4 * kvh + (prompt ? (wave >> 1) : wave), q0 = prompt ? 32 * (wave & 1) : 0;
        const int mq = (prompt ? b * 4096 + 64 * c : MP + b * 32) + q0 + (lane & 31);
        bf16x8 qf[4];
#pragma unroll
        for (int ks = 0; ks < 4; ++ks) qf[ks] = *(const bf16x8*)(QKV + (size_t)mq * NQKV + head * 64 + ks * 16 + (lane >> 5) * 8);
        f32x16 o[2];
#pragma unroll
        for (int db = 0; db < 2; ++db)
#pragma unroll
            for (int e = 0; e < 16; ++e) o[db][e] = 0.f;
        const float sink2 = F.in[11][head] * LOG2E;
        float mrun = sink2, lrun = 0.f;
        SwaScore sf; sf.lut = (const LAS float*)(F.lds + SWA_LUT_OFF) + head * 256; sf.qi = q0 + (lane & 31); sf.hh = lane >> 5; sf.sc2 = 0.125f * LOG2E;
        if (prompt) { sf.jlo = 128 - 64 * c; sf.jhi = 192; } else { sf.jlo = 0; sf.jhi = 160; }
        attn_group<64, 6, SWA_KSTR, SWA_VSTR>(Kl, Vl, qf, o, mrun, lrun, lane, sf);
        const float den = lrun + __builtin_amdgcn_exp2f(sink2 - mrun);
        attn_store<64>(o, 1.0f / den, MIX + (size_t)mq * DM + head * 64, lane);
    }
}

constexpr int CA_KSTR = 272, CA_VSTR = 320, CA_K_OFF = 0, CA_V_OFF = 128 * CA_KSTR  ;
struct PlainScore { float sc2; __device__ __forceinline__ float operator()(int, int, float raw) const { return raw * sc2; } };
__device__ __forceinline__ void ca_unit(Frame& F, int u) {
    const bool prompt = u < 256; const int hd = u & 3; int mbase, bidx;
    if (prompt) { const int tile = u >> 2; mbase = tile * 256; bidx = tile >> 4; } else { const int b = (u - 256) >> 2; mbase = MP + b * 32; bidx = 4 + b; }
    const bf16* QC = (const bf16*)(F.ws + WS_RKV); bf16* OC = (bf16*)(F.ws + WS_XN);
    const bf16* MKB = (const bf16*)(F.ws + WS_MKB) + (size_t)bidx * 256 * 512 + hd * 128; const bf16* MVB = (const bf16*)(F.ws + WS_MVB) + (size_t)bidx * 256 * 512 + hd * 128;
    LAS unsigned char* Kl = F.lds + CA_K_OFF; LAS unsigned char* Vl = F.lds + CA_V_OFF;
    const int wave = F.wave, lane = F.lane; const bool active = prompt || wave == 0;
    const int mq = mbase + (prompt ? 32 * wave : 0) + (lane & 31);
    bf16x8 qf[8]; f32x16 o[4]; float mrun = -INFINITY, lrun = 0.f;
    if (active) {
#pragma unroll
        for (int ks = 0; ks < 8; ++ks) qf[ks] = *(const bf16x8*)(QC + (size_t)mq * 512 + hd * 128 + ks * 16 + (lane >> 5) * 8);
    }
#pragma unroll
    for (int db = 0; db < 4; ++db)
#pragma unroll
        for (int e = 0; e < 16; ++e) o[db][e] = 0.f;
    PlainScore sf; sf.sc2 = 0.08838834764831845f * LOG2E;
    for (int g = 0; g < 2; ++g) {
        __syncthreads();
        for (int idx = F.tid; idx < 128 * 16; idx += NTHR) { const int j = idx >> 4, c8 = idx & 15;
            *(LAS v4u*)(Kl + j * CA_KSTR + c8 * 16) = *(const v4u*)(MKB + (size_t)(g * 128 + j) * 512 + 8 * c8);
            *(LAS v4u*)(Vl + j * CA_VSTR + c8 * 16) = *(const v4u*)(MVB + (size_t)(g * 128 + j) * 512 + 8 * c8); }
        __syncthreads();
        if (active) attn_group<128, 4, CA_KSTR, CA_VSTR>(Kl, Vl, qf, o, mrun, lrun, lane, sf);
    }
    if (active) attn_store<128>(o, 1.0f / lrun, OC + (size_t)mq * 512 + hd * 128, lane);
}

__device__ __forceinline__ void p11_final(Frame& F) {
    const int gw = F.vcu * NWAVES + F.wave, NGW = F.G * NWAVES; const float* PART = (const float*)(F.ws + WS_PART3); const float* g = F.in[34];
    for (int m = gw; m < MALL; m += NGW) {
        const f32x4 p0 = *(const f32x4*)(PART + (size_t)m * 16), p1 = *(const f32x4*)(PART + (size_t)m * 16 + 4), p2 = *(const f32x4*)(PART + (size_t)m * 16 + 8), p3 = *(const f32x4*)(PART + (size_t)m * 16 + 12);
        const float ss = ((p0[0] + p0[1]) + (p0[2] + p0[3])) + ((p1[0] + p1[1]) + (p1[2] + p1[3])) + ((p2[0] + p2[1]) + (p2[2] + p2[3])) + ((p3[0] + p3[1]) + (p3[2] + p3[3]));
        const float rs = 1.0f / sqrtf(ss * (1.f / 1024.f) + NORM_EPS);
        f32x4* xr = (f32x4*)(F.out + (size_t)m * DM) + F.lane; const f32x4* gr = (const f32x4*)g + F.lane;
#pragma unroll
        for (int j = 0; j < 4; ++j) { f32x4 v = xr[64 * j]; const f32x4 gg = gr[64 * j]; v = v * rs; v[0] *= gg[0]; v[1] *= gg[1]; v[2] *= gg[2]; v[3] *= gg[3]; xr[64 * j] = v; }
    }
}

#ifndef MK_SPLIT
#define MK_SPLIT 0
#endif
constexpr int N_PHASES = 13;
struct Args { const float* in[35]; float* out; unsigned char* ws; int ph_lo, ph_hi; };
static_assert(sizeof(Args) == 35 * 8 + 8 + 8 + 8, "Args has no padding");

__global__ void __launch_bounds__(NTHR, 2) hymba_fwd(Args args) {
    extern __shared__ __attribute__((aligned(16))) unsigned char lds_raw[];
    Frame F;
    F.lds = (LAS unsigned char*)lds_raw; F.MISC = (volatile LAS unsigned*)(F.lds + MISC_OFF);
    F.tid = threadIdx.x; F.lane = F.tid & 63; F.wave = __builtin_amdgcn_readfirstlane(F.tid >> 6);
    F.G = gridDim.x; { const int bx = blockIdx.x; F.vcu = (F.G % 8 == 0) ? (bx % 8) * (F.G / 8) + bx / 8 : bx; }
    F.in = args.in; F.out = args.out; F.ws = args.ws; F.ctl = (gu32*)(args.ws + WS_CTL);
    unsigned char* ws = args.ws;
    for (int u = F.tid; u < (LDS_BYTES - LDSCTL_OFF) / 4; u += NTHR) ((LAS unsigned*)(F.lds + LDSCTL_OFF))[u] = 0u;
    __syncthreads();
    XcdBarrier bar; bar.bar = (unsigned*)(F.ctl + CW_BAR); bar.x = 0; bar.st = nullptr;
    const int lo = args.ph_lo, hi = args.ph_hi;
    if (hi - lo > 1) bar = xcd_barrier_post((unsigned*)(F.ctl + CW_BAR), F.MISC + 8);
#define IN(k) (lo <= (k) && (k) < hi)
#define SEAM(k) do { if (IN(k) && IN((k) + 1)) xcd_barrier(bar); } while (0)
    const int bx = (int)blockIdx.x;

    if (IN(0)) { p0_prologue(F); } SEAM(0);
    if (IN(1)) {
        { pg8::Gemm g{(const pg8::bf16_t*)(ws + WS_XN), (const pg8::bf16_t*)(ws + WS_WIN), MALL, 2560, 1024}; pg8::StaticOrder S; S.init(MALL, 2560, F.G, bx);
          EpiIn E{(bf16*)(ws + WS_QKV), (bf16*)(ws + WS_ZR), F.out};
          pg8::gemm_phase<EpiIn, pg8::StaticOrder, true, true>(F.lds, g, S, E); }
        { pg8::Gemm g{(const pg8::bf16_t*)(ws + WS_MN), (const pg8::bf16_t*)(ws + WS_WMKV), 1024, 1024, 1024}; pg8::StaticOrder S; S.init(1024, 1024, F.G, (bx + 96) % F.G);
          EpiMemKV E{(bf16*)(ws + WS_MKB), (bf16*)(ws + WS_MVB), F.out};
          pg8::gemm_phase<EpiMemKV, pg8::StaticOrder, true, true>(F.lds, g, S, E); }
    } SEAM(1);
    if (IN(2)) { p2_prep(F); } SEAM(2);
    if (IN(3)) {
        pg8::Gemm g{(const pg8::bf16_t*)(ws + WS_AP), (const pg8::bf16_t*)(ws + WS_WLORA), MALL, 1536, 256}; pg8::StaticOrder S; S.init(MALL, 1536, F.G, bx);
        EpiLora E{(float*)(ws + WS_LW), (bf16*)(ws + WS_AH), (bf16*)(ws + WS_G), F.in[14], F.in[16]};
        pg8::gemm_phase<EpiLora, pg8::StaticOrder, true, true>(F.lds, g, S, E);
    } SEAM(3);
    if (IN(4)) {
        const int nscan = 192;
        for (int j = F.vcu; j < nscan; j += F.G) { __syncthreads(); p4_scan_job(F, j); }
        const int na = F.G > 64 ? F.G - 64 : F.G, a0 = F.G > 64 ? F.vcu - 64 : F.vcu;
        if (a0 >= 0) { __syncthreads(); swa_build_lut(F);
            for (int u = a0; u < 528; u += na) swa_unit(F, u); }
    } SEAM(4);
    if (IN(5)) { p4b_post(F); } SEAM(5);
    if (IN(6)) {
        pg8::Gemm g{(const pg8::bf16_t*)(ws + WS_XN), (const pg8::bf16_t*)(ws + WS_WOUT), MALL, 1024, 1024}; pg8::StaticOrder S; S.init(MALL, 1024, F.G, bx);
        EpiRes E{F.in[0], F.in[1], F.out, (bf16*)(ws + WS_XB), (float*)(ws + WS_PART1)};
        pg8::gemm_phase<EpiRes, pg8::StaticOrder, true, true>(F.lds, g, S, E);
    } SEAM(6);
    if (IN(7)) {
        pg8::Gemm g{(const pg8::bf16_t*)(ws + WS_XB), (const pg8::bf16_t*)(ws + WS_WCQ), MALL, 512, 1024}; pg8::StaticOrder S; S.init(MALL, 512, F.G, bx);
        EpiNormBf16<0> E{(bf16*)(ws + WS_RKV), 512, (const float*)(ws + WS_PART1), 1.0f};
        pg8::gemm_phase<EpiNormBf16<0>, pg8::StaticOrder, true, true>(F.lds, g, S, E);
    } SEAM(7);
    if (IN(8)) { for (int u = F.vcu; u < 288; u += F.G) ca_unit(F, u); } SEAM(8);
    if (IN(9)) {
        pg8::Gemm g{(const pg8::bf16_t*)(ws + WS_XN), (const pg8::bf16_t*)(ws + WS_WCO), MALL, 1024, 512}; pg8::StaticOrder S; S.init(MALL, 1024, F.G, bx);
        EpiRes E{F.out, F.out + (size_t)MP * DM, F.out, (bf16*)(ws + WS_XB), (float*)(ws + WS_PART2)};
        pg8::gemm_phase<EpiRes, pg8::StaticOrder, true, true>(F.lds, g, S, E);
    } SEAM(9);
    if (IN(10)) {
        pg8::Gemm g{(const pg8::bf16_t*)(ws + WS_XB), (const pg8::bf16_t*)(ws + WS_WUP), MALL, 4096, 1024}; pg8::StaticOrder S; S.init(MALL, 4096, F.G, bx);
        EpiNormBf16<1> E{(bf16*)(ws + WS_H), 4096, (const float*)(ws + WS_PART2), 1.0f};
        pg8::gemm_phase<EpiNormBf16<1>, pg8::StaticOrder, true, true>(F.lds, g, S, E);
    } SEAM(10);
    if (IN(11)) {
        pg8::Gemm g{(const pg8::bf16_t*)(ws + WS_H), (const pg8::bf16_t*)(ws + WS_WDN), MALL, 1024, 4096}; pg8::StaticOrder S; S.init(MALL, 1024, F.G, bx);
        EpiRes E{F.out, F.out + (size_t)MP * DM, F.out, nullptr, (float*)(ws + WS_PART3)};
        pg8::gemm_phase<EpiRes, pg8::StaticOrder, true, true>(F.lds, g, S, E);
    } SEAM(11);
    if (IN(12)) { p11_final(F); }
#undef IN
#undef SEAM
}

extern "C" void kernel_launch(void* const* d_in, const int* in_sizes, int n_in, void* d_out, int out_size, void* d_ws, size_t ws_size, hipStream_t stream) {
    static int grid = 0;
    if (grid == 0) {
        if (n_in != 35 || out_size != (int)OUT_TOTAL || ws_size < WS_END) { fprintf(stderr, "kernel_launch: unexpected shapes: n_in %d out %d ws %zu\n", n_in, out_size, ws_size); grid = -1; return; }
        int dev = 0, cus = 0, per_cu = 0;
        if (hipGetDevice(&dev) != hipSuccess || hipDeviceGetAttribute(&cus, hipDeviceAttributeMultiprocessorCount, dev) != hipSuccess) { grid = -1; return; }
        if (hipFuncSetAttribute((const void*)hymba_fwd, hipFuncAttributeMaxDynamicSharedMemorySize, LDS_BYTES) != hipSuccess) { fprintf(stderr, "kernel_launch: hipFuncSetAttribute failed\n"); grid = -1; return; }
        if (hipOccupancyMaxActiveBlocksPerMultiprocessor(&per_cu, (const void*)hymba_fwd, NTHR, LDS_BYTES) != hipSuccess || per_cu < 1)
            fprintf(stderr, "kernel_launch: occupancy query reports %d workgroups per CU\n", per_cu);
        (void)hipGetLastError();
        grid = cus;
    }
    if (grid < 0) return;
    if (hipMemsetAsync((char*)d_ws + WS_CTL, 0, CTL_ZERO_BYTES, stream) != hipSuccess) { fprintf(stderr, "kernel_launch: memset failed\n"); return; }
    Args a{};
    for (int i = 0; i < 35; ++i) a.in[i] = (const float*)d_in[i];
    a.out = (float*)d_out; a.ws = (unsigned char*)d_ws;
#if MK_SPLIT
    for (int p = 0; p < N_PHASES; ++p) { a.ph_lo = p; a.ph_hi = p + 1; hipLaunchKernelGGL(hymba_fwd, dim3(grid), dim3(NTHR), LDS_BYTES, stream, a); }
#else
    a.ph_lo = 0; a.ph_hi = N_PHASES; hipLaunchKernelGGL(hymba_fwd, dim3(grid), dim3(NTHR), LDS_BYTES, stream, a);
#endif
    const hipError_t le = hipPeekAtLastError();
    if (le != hipSuccess) fprintf(stderr, "kernel_launch: launch failed: %s\n", hipGetErrorName(le));
}
```

```cpp
#define MK_SPLIT 0
#define PROBE_PHASE -1
#include <hip/hip_runtime.h>
#include <cstdio>
#include <cstdint>
namespace pg8 {
#define PG8_LAS __attribute__((address_space(3)))
typedef unsigned short bf16_t;
typedef short bf16x8 __attribute__((ext_vector_type(8)));
typedef float f32x4 __attribute__((ext_vector_type(4)));
typedef unsigned u32x4 __attribute__((ext_vector_type(4)));
constexpr int BM = 256, BK = 64, HALF = 128, HTB = HALF * BK * 2  , STAGE_BYTES = 8 * HTB, NXCD = 8, WGM = 8;

__host__ __device__ __forceinline__ int lds_byte(int r, int c) { const int st = (r >> 4) * 2 + (c >> 5), rr = r & 15, cc = c & 31, ob = rr * 64 + cc * 2; return st * 1024 + (ob ^ (((ob >> 9) & 1) << 5)); }
__host__ __device__ __forceinline__ void stage_rc(int b, int& R, int& C) { const int st = b / 1024, sb = b % 1024, swz = sb ^ (((sb >> 9) & 1) << 5); R = (st >> 1) * 16 + swz / 64; C = (st & 1) * 32 + (swz % 64) / 2; }
__host__ __device__ __forceinline__ int perm32(int rho) { const int n = rho >> 4, i = rho & 15; return 8 * (i >> 2) + 4 * n + (i & 3); }

struct Unit { int pm, pn; };
struct Gemm { const bf16_t* A; const bf16_t* Bt; int M, N, K; };

struct StaticOrder {
    int nM, nN, nwg, G, c;
    __host__ __device__ void init(int M, int N, int G_, int c_) { nM = M / BM; nN = N / BM; nwg = nM * nN; G = G_; c = c_; }
    __host__ __device__ bool next(int i, Unit& u) const {
        const long L = (long)i * G + c; if (L >= nwg) return false;
        int wgid = (int)L; { const int q = nwg / NXCD, r = nwg % NXCD, xcd = wgid % NXCD, off = wgid / NXCD; wgid = (xcd < r ? xcd * (q + 1) : r * (q + 1) + (xcd - r) * q) + off; }
        const int nig = WGM * nN, gid = wgid / nig, fm = gid * WGM, gsz = (nM - fm) < WGM ? (nM - fm) : WGM;
        u.pm = fm + ((wgid % nig) % gsz); u.pn = (wgid % nig) / gsz; return true;
    }
    __device__ __forceinline__ void a_ready(const Unit&) const {}
    __device__ __forceinline__ void done(const Unit&) const {}
};

__device__ __forceinline__ unsigned cvt_pk_bf16(float lo, float hi) { unsigned r; asm volatile("v_cvt_pk_bf16_f32 %0, %1, %2" : "=v"(r) : "v"(lo), "v"(hi)); return r; }
template <class Epi, class Sched, bool ALIGN_EPI = false, bool SP2 = false>
__device__ __forceinline__ void gemm_phase(PG8_LAS unsigned char* lds, const Gemm g, const Sched& S, const Epi& E) {
    const int tid = threadIdx.x, wid = __builtin_amdgcn_readfirstlane(tid >> 6), lane = tid & 63, wr = wid >> 2, wc = wid & 3, fr = lane & 15, fq = lane >> 4;
    const int K = g.K, nt = K / BK;
    unsigned voffA[2], voffB[2];
#pragma unroll
    for (int i = 0; i < 2; ++i) { int R, C; stage_rc(tid * 16 + i * 8192, R, C); const int Rb = Epi::PERM ? ((R & ~31) + perm32(R & 31)) : R;
        voffA[i] = (unsigned)(R * K + C) * 2u; voffB[i] = (unsigned)(Rb * K + C) * 2u; }
    const size_t kstep = (size_t)(BK * 2);
    const size_t hstep = (size_t)HALF * K * 2;
    const size_t tstep = 2 * hstep;
    const unsigned ldsw = (unsigned)wid * 1024u;
    const int aoff = lds_byte(wr * 64 + fr, fq * 8), boff = lds_byte(wc * 32 + fr, fq * 8);
#define PG8_SA(b, h) (((b) * 2 + (h)) * HTB)
#define PG8_SB(b, h) ((4 + (b) * 2 + (h)) * HTB)
#define PG8_STAGE(bufoff, gbase, voff) do { _Pragma("unroll") for (int _i = 0; _i < 2; ++_i) \
        __builtin_amdgcn_global_load_lds((const unsigned*)((const char*)(gbase) + (voff)[_i]), (PG8_LAS unsigned*)(lds + (bufoff) + ldsw + _i * 8192), 16, 0, 0); } while (0)
#define PG8_LDA(dst, b, h) do { _Pragma("unroll") for (int m = 0; m < 4; ++m) _Pragma("unroll") for (int k = 0; k < 2; ++k) dst[m][k] = *(const PG8_LAS bf16x8*)(lds + PG8_SA(b, h) + aoff + m * 2048 + k * 1024); } while (0)
#define PG8_LDB(dst, b, h) do { _Pragma("unroll") for (int n = 0; n < 2; ++n) _Pragma("unroll") for (int k = 0; k < 2; ++k) dst[n][k] = *(const PG8_LAS bf16x8*)(lds + PG8_SB(b, h) + boff + n * 2048 + k * 1024); } while (0)
#define PG8_MMA(ai, bj, At, Bt) do { __builtin_amdgcn_s_setprio(1); _Pragma("unroll") for (int m = 0; m < 4; ++m) _Pragma("unroll") for (int n = 0; n < 2; ++n) _Pragma("unroll") for (int k = 0; k < 2; ++k) \
        acc[ai][bj][m][n] = __builtin_amdgcn_mfma_f32_16x16x32_bf16(Bt[n][k], At[m][k], acc[ai][bj][m][n], 0, 0, 0); __builtin_amdgcn_s_setprio(0); } while (0)
#define PG8_WAIT_V(n) asm volatile("s_waitcnt vmcnt(" #n ")" ::: "memory")
#define PG8_WAIT_L(n) asm volatile("s_waitcnt lgkmcnt(" #n ")" ::: "memory")
#define PG8_BAR __builtin_amdgcn_s_barrier()
#define PG8_SCHED __builtin_amdgcn_sched_barrier(0)
    Unit cur, nxt; int ui = 0;
    if (!S.next(0, cur)) return;
    f32x4 acc[2][2][4][2];
#pragma unroll
    for (int a = 0; a < 2; ++a)
#pragma unroll
        for (int b = 0; b < 2; ++b)
#pragma unroll
            for (int m = 0; m < 4; ++m)
#pragma unroll
                for (int n = 0; n < 2; ++n) acc[a][b][m][n] = (f32x4){0.f, 0.f, 0.f, 0.f};
    bf16x8 At[4][2], B0[2][2], B1[2][2];
    const char* cA = (const char*)g.A + (size_t)cur.pm * tstep; const char* cB = (const char*)g.Bt + (size_t)cur.pn * tstep;
    S.a_ready(cur);
    if constexpr (SP2) {
        PG8_STAGE(PG8_SB(0, 0), cB, voffB); PG8_STAGE(PG8_SB(0, 1), cB + hstep, voffB); PG8_STAGE(PG8_SA(0, 0), cA, voffA); PG8_STAGE(PG8_SA(0, 1), cA + hstep, voffA);
        if (wr == 1) PG8_BAR;
        PG8_WAIT_V(2); PG8_BAR;
        PG8_STAGE(PG8_SB(1, 0), cB + kstep, voffB); PG8_STAGE(PG8_SA(1, 0), cA + kstep, voffA); PG8_STAGE(PG8_SB(1, 1), cB + hstep + kstep, voffB);
        PG8_WAIT_V(6); PG8_BAR;
    } else {
        PG8_STAGE(PG8_SB(0, 0), cB, voffB); PG8_STAGE(PG8_SA(0, 0), cA, voffA); PG8_STAGE(PG8_SB(0, 1), cB + hstep, voffB); PG8_STAGE(PG8_SA(0, 1), cA + hstep, voffA);
        if (wr == 1) PG8_BAR;
        PG8_WAIT_V(4); PG8_BAR;
        PG8_STAGE(PG8_SB(1, 0), cB + kstep, voffB); PG8_STAGE(PG8_SA(1, 0), cA + kstep, voffA); PG8_STAGE(PG8_SB(1, 1), cB + hstep + kstep, voffB);
        PG8_WAIT_V(6); PG8_BAR;
    }
    for (;;) {
        const bool has_next = S.next(ui + 1, nxt);
        const char* nA = has_next ? (const char*)g.A + (size_t)nxt.pm * tstep : cA; const char* nB = has_next ? (const char*)g.Bt + (size_t)nxt.pn * tstep : cB;
        for (int t = 0; t < nt; t += 2) {
            const bool last = (t == nt - 2);
            const char* a1 = cA + (size_t)(t + 1) * kstep;
            const char* a2 = last ? nA : cA + (size_t)(t + 2) * kstep; const char* b2 = last ? nB : cB + (size_t)(t + 2) * kstep;
            const char* a3 = a2 + kstep; const char* b3 = b2 + kstep;
            if (last && has_next) S.a_ready(nxt);
            if constexpr (SP2) {
            PG8_LDB(B0, 0, 0); PG8_LDB(B1, 0, 1); PG8_SCHED; PG8_LDA(At, 0, 0); PG8_STAGE(PG8_SA(1, 1), a1 + hstep, voffA);
            PG8_WAIT_V(8); PG8_WAIT_L(0); PG8_BAR; PG8_MMA(0, 0, At, B0); PG8_MMA(0, 1, At, B1); PG8_BAR; PG8_SCHED;
            PG8_LDA(At, 0, 1); PG8_STAGE(PG8_SB(0, 0), b2, voffB); PG8_STAGE(PG8_SB(0, 1), b2 + hstep, voffB); PG8_STAGE(PG8_SA(0, 0), a2, voffA);
            PG8_WAIT_V(8); PG8_WAIT_L(0); PG8_BAR; PG8_MMA(1, 0, At, B0); PG8_MMA(1, 1, At, B1); PG8_BAR; PG8_SCHED;
            PG8_LDB(B0, 1, 0); PG8_LDB(B1, 1, 1); PG8_SCHED; PG8_LDA(At, 1, 0); PG8_STAGE(PG8_SA(0, 1), a2 + hstep, voffA);
            PG8_WAIT_V(8); PG8_WAIT_L(0); PG8_BAR; PG8_MMA(0, 0, At, B0); PG8_MMA(0, 1, At, B1); PG8_BAR; PG8_SCHED;
            PG8_LDA(At, 1, 1); PG8_STAGE(PG8_SB(1, 0), b3, voffB); PG8_STAGE(PG8_SB(1, 1), b3 + hstep, voffB); PG8_STAGE(PG8_SA(1, 0), a3, voffA);
            PG8_WAIT_V(8); PG8_WAIT_L(0); PG8_BAR; PG8_MMA(1, 0, At, B0); PG8_MMA(1, 1, At, B1); PG8_BAR; PG8_SCHED;
            } else {
            PG8_LDB(B0, 0, 0); PG8_SCHED; PG8_LDA(At, 0, 0); PG8_STAGE(PG8_SA(1, 1), a1 + hstep, voffA);
            PG8_WAIT_L(8); PG8_BAR; PG8_WAIT_L(0); PG8_MMA(0, 0, At, B0); PG8_BAR; PG8_SCHED;
            PG8_LDB(B1, 0, 1); PG8_STAGE(PG8_SB(0, 0), b2, voffB);
            PG8_BAR; PG8_WAIT_L(0); PG8_MMA(0, 1, At, B1); PG8_BAR;
            PG8_LDA(At, 0, 1); PG8_STAGE(PG8_SA(0, 0), a2, voffA);
            PG8_BAR; PG8_WAIT_L(0); PG8_MMA(1, 0, At, B0); PG8_BAR; PG8_SCHED;
            PG8_STAGE(PG8_SB(0, 1), b2 + hstep, voffB);
            PG8_WAIT_V(6); PG8_BAR; PG8_MMA(1, 1, At, B1); PG8_BAR;
            PG8_LDB(B0, 1, 0); PG8_SCHED; PG8_LDA(At, 1, 0); PG8_STAGE(PG8_SA(0, 1), a2 + hstep, voffA);
            PG8_WAIT_L(8); PG8_BAR; PG8_WAIT_L(0); PG8_MMA(0, 0, At, B0); PG8_BAR; PG8_SCHED;
            PG8_LDB(B1, 1, 1); PG8_STAGE(PG8_SB(1, 0), b3, voffB);
            PG8_BAR; PG8_WAIT_L(0); PG8_MMA(0, 1, At, B1); PG8_BAR;
            PG8_LDA(At, 1, 1); PG8_STAGE(PG8_SA(1, 0), a3, voffA);
            PG8_BAR; PG8_WAIT_L(0); PG8_MMA(1, 0, At, B0); PG8_BAR; PG8_SCHED;
            PG8_STAGE(PG8_SB(1, 1), b3 + hstep, voffB);
            PG8_WAIT_V(6); PG8_BAR; PG8_MMA(1, 1, At, B1); PG8_BAR;
            }
        }
        if constexpr (ALIGN_EPI) { if (wr == 0) PG8_BAR; }
        if constexpr (!Epi::AFTER_DRAIN) { E(acc, cur, wr, wc, fr, fq); S.done(cur); }
        if (!has_next) break;
#pragma unroll
        for (int a = 0; a < 2; ++a)
#pragma unroll
            for (int b = 0; b < 2; ++b)
#pragma unroll
                for (int m = 0; m < 4; ++m)
#pragma unroll
                    for (int n = 0; n < 2; ++n) acc[a][b][m][n] = (f32x4){0.f, 0.f, 0.f, 0.f};
        cur = nxt; cA = nA; cB = nB; ++ui;
        if constexpr (ALIGN_EPI) { if (wr == 1) PG8_BAR; }
    }
    PG8_WAIT_V(0);
    if constexpr (!ALIGN_EPI) { if (wr == 0) PG8_BAR; }
    PG8_BAR;
    if constexpr (Epi::AFTER_DRAIN) { E.fused(acc, cur, wr, wc, fr, fq, lds, wid, lane); S.done(cur); }
#undef PG8_SA
#undef PG8_SB
#undef PG8_STAGE
#undef PG8_LDA
#undef PG8_LDB
#undef PG8_MMA
#undef PG8_WAIT_V
#undef PG8_WAIT_L
#undef PG8_BAR
#undef PG8_SCHED
}
}
#define GAS __attribute__((address_space(1)))
#define LAS __attribute__((address_space(3)))
typedef unsigned short bf16;
typedef unsigned v4u __attribute__((ext_vector_type(4)));
typedef float f32x4 __attribute__((ext_vector_type(4)));
typedef short bf16x8 __attribute__((ext_vector_type(8)));
typedef GAS unsigned gu32;
typedef GAS unsigned long long gu64;
#define RLX_AGENT __ATOMIC_RELAXED, __HIP_MEMORY_SCOPE_AGENT
#define LDS_WAIT() asm volatile("s_waitcnt lgkmcnt(0)" ::: "memory")
#define VM_WAIT() asm volatile("s_waitcnt vmcnt(0)" ::: "memory")
__device__ __forceinline__ unsigned long long rt() { return __builtin_amdgcn_s_memrealtime(); }
__device__ __forceinline__ unsigned f2bf(float f) { unsigned u = __builtin_bit_cast(unsigned, f); return (u + 0x7fffu + ((u >> 16) & 1u)) >> 16; }
__device__ __forceinline__ unsigned pk2(float lo, float hi) { return f2bf(lo) | (f2bf(hi) << 16); }
#define XB_TMO      128
#define XB_XCNT(j)  (256  + 64 * (j))
#define XB_XSUB(j)  (1280 + 64 * (j))
#define XB_XGEN(j)  (2304 + 64 * (j))
#define XB_TOP      3328
#define XB_TOPGEN   3392
#define XCD_BAR_WORDS 3456
#define XB_SPIN_CAP (1u << 18)

__device__ __forceinline__ unsigned xb_ld(unsigned* p)              { return __hip_atomic_load(p, __ATOMIC_RELAXED, __HIP_MEMORY_SCOPE_AGENT); }
__device__ __forceinline__ unsigned xb_add(unsigned* p, unsigned v) { return __hip_atomic_fetch_add(p, v, __ATOMIC_RELAXED, __HIP_MEMORY_SCOPE_AGENT); }
__device__ __forceinline__ unsigned xb_xcc_id() { return (unsigned)__builtin_amdgcn_s_getreg((3 << 11) | 20) & 0xFu; }
#define XB_SPIN(cond, bar) do { unsigned _sp = 0; while (cond) { __builtin_amdgcn_s_sleep(1); \
    if ((++_sp & 255u) == 0u) { if (xb_ld(&(bar)[XB_TMO])) break; if (_sp > XB_SPIN_CAP) { atomicAdd(&(bar)[XB_TMO], 1u); break; } } } } while (0)

struct XcdBarrier {
    unsigned* bar; unsigned x;
    volatile LAS unsigned* st;
};

__device__ __forceinline__ XcdBarrier xcd_barrier_post(unsigned* bar, volatile LAS unsigned* st) {
    XcdBarrier b; b.bar = bar; b.x = xb_xcc_id(); b.st = st;
    if (threadIdx.x == 0) (void)xb_add(&bar[XB_XCNT(b.x)], 1u);
    return b;
}
__device__ __forceinline__ void xcd_barrier_complete(unsigned* bar, unsigned x, unsigned& nloc, unsigned& nx) {
    const unsigned G = gridDim.x * gridDim.y * gridDim.z;
    unsigned sum, cnt, mine, sp = 0u;
    for (;;) {
        sum = 0u; cnt = 0u; mine = 0u;
#pragma unroll
        for (unsigned j = 0; j < 16; ++j) { const unsigned c = xb_ld(&bar[XB_XCNT(j)]); sum += c; cnt += (c > 0u) ? 1u : 0u; mine = (j == x) ? c : mine; }
        if (sum == G) break;
        __builtin_amdgcn_s_sleep(1);
        if ((++sp & 255u) == 0u) { if (xb_ld(&bar[XB_TMO])) break; if (sp > XB_SPIN_CAP) { atomicAdd(&bar[XB_TMO], 1u); break; } }
    }
    nloc = mine > 0u ? mine : 1u; nx = cnt > 0u ? cnt : 1u;
}

__device__ __forceinline__ void xcd_barrier(const XcdBarrier& b) {
    asm volatile("s_waitcnt vmcnt(0)" ::: "memory");
    __syncthreads();
    if (threadIdx.x == 0) {
        unsigned* bar = b.bar;
        __builtin_amdgcn_s_waitcnt(0);
        unsigned nloc = b.st[0], nx = b.st[1];
        if (nloc == 0u) { xcd_barrier_complete(bar, b.x, nloc, nx); b.st[0] = nloc; b.st[1] = nx; }
        const unsigned old = xb_add(&bar[XB_XSUB(b.x)], 1u);
        const unsigned gen = old / nloc;
        if (old + 1u == (gen + 1u) * nloc) {
            __builtin_amdgcn_fence(__ATOMIC_RELEASE, "agent");
            asm volatile("s_waitcnt vmcnt(0)" ::: "memory");
            const unsigned og = xb_add(&bar[XB_TOP], 1u);
            const unsigned tg = og / nx;
            if (og + 1u == (tg + 1u) * nx) xb_add(&bar[XB_TOPGEN], 1u);
            else XB_SPIN(xb_ld(&bar[XB_TOPGEN]) == tg, bar);
            __builtin_amdgcn_fence(__ATOMIC_ACQUIRE, "agent");
            xb_add(&bar[XB_XGEN(b.x)], 1u);
            asm volatile("s_waitcnt vmcnt(0)" ::: "memory");
        } else {
            XB_SPIN(xb_ld(&bar[XB_XGEN(b.x)]) == gen, bar);
            __builtin_amdgcn_fence(__ATOMIC_ACQUIRE, "agent");
            asm volatile("s_waitcnt vmcnt(0)" ::: "memory");
        }
    }
    __syncthreads();
}

constexpr int NWAVES = 8, NTHR = 512;
constexpr int DM = 1024, MP = 16384, MS = 256, MALL = 16640;
constexpr int NQKV = 768, NZR = 1792, RW = 512, DFF = 4096, MEMW = 512;
constexpr float LOG2E = 1.4426950408889634f;
constexpr float NORM_EPS = 1e-6f, GN_EPS = 64e-5f;

constexpr size_t OFF_Y = 0, OFF_PK = 17039360, OFF_PV = 17104896, OFF_PMK = 17170432, OFF_PMV = 17694720, OFF_PSH = 18219008, OFF_PWKV = 18226176,
                 OFF_SK = 18357248, OFF_SV = 18488320, OFF_SSH = 18619392, OFF_SWKV = 18633728, OUT_TOTAL = 18895872;
constexpr size_t KiB = 1024, MiB = 1u << 20;
constexpr size_t WS_CTL = 0, CTL_ZERO_BYTES = 64 * KiB;
constexpr size_t WS_WIN = 1 * MiB, WS_WOUT = 6 * MiB, WS_WCQ = 8 * MiB, WS_WCO = 9 * MiB, WS_WUP = 10 * MiB, WS_WDN = 18 * MiB, WS_WMKV = 26 * MiB, WS_WLORA = 28 * MiB;
constexpr size_t PART_BYTES = 1114112;
constexpr size_t WS_PART1 = 28 * MiB + 768 * KiB, WS_PART2 = WS_PART1 + PART_BYTES, WS_PART3 = WS_PART2 + PART_BYTES;
constexpr size_t WS_XN = 32 * MiB;
constexpr size_t WS_MN = 64 * MiB + 512 * KiB;
constexpr size_t WS_MKB = 66 * MiB + 512 * KiB, WS_MVB = 69 * MiB + 512 * KiB;
constexpr size_t WS_QKV = 73 * MiB;
constexpr size_t WS_RKV = 97 * MiB + 512 * KiB;
constexpr size_t WS_ZR = 146 * MiB + 256 * KiB;
constexpr size_t WS_LW = WS_ZR, WS_G = 178 * MiB + 768 * KiB;
constexpr size_t WS_AP = 203 * MiB + 256 * KiB;
constexpr size_t WS_AH = 211 * MiB + 512 * KiB;
constexpr size_t WS_XB = 211 * MiB + 512 * KiB;
constexpr size_t WS_H = 73 * MiB;
constexpr size_t WS_GB = WS_AP, WS_HB = WS_AP + 2 * MiB;
constexpr size_t WS_BON = WS_PART3;
constexpr size_t WS_END = 244 * MiB;
static_assert(WS_PART3 + PART_BYTES <= WS_XN && WS_XN + (size_t)MALL * DM * 2 <= WS_MN && WS_MVB + 3 * MiB <= WS_QKV, "ws map 1");
static_assert(WS_QKV + (size_t)MALL * NQKV * 2 <= WS_RKV && WS_RKV + (size_t)MALL * 1536 * 2 <= WS_ZR && WS_ZR + (size_t)MALL * NZR * 2 <= WS_AP, "ws map 2");
static_assert(WS_LW + (size_t)MALL * 512 * 4 <= WS_G && WS_G + (size_t)MALL * 512 * 2 <= WS_AP && WS_AP + (size_t)MALL * 256 * 2 <= WS_AH, "ws map 3");
static_assert(WS_XB + (size_t)MALL * DM * 2 <= WS_END && WS_H + (size_t)MALL * DFF * 2 <= WS_AP, "ws map 4");
constexpr int CW_BAR = 4096;

constexpr int RING_BYTES = 131072, LDSCTL_OFF = RING_BYTES, MISC_OFF = LDSCTL_OFF + 320, LDS_BYTES = 147456;

typedef float f32x16 __attribute__((ext_vector_type(16)));
typedef short bf16x4 __attribute__((ext_vector_type(4)));
typedef unsigned u32x2 __attribute__((ext_vector_type(2)));

__device__ __forceinline__ float bf2f(unsigned short b) { return __uint_as_float((unsigned)b << 16); }
__device__ __forceinline__ float wave_sum(float v) {
#pragma unroll
    for (int o = 1; o < 64; o <<= 1) v += __shfl_xor(v, o);
    return v;
}
__device__ __forceinline__ float sigmoidf_(float x) { return 1.0f / (1.0f + __expf(-x)); }

typedef const float* CFP; typedef __attribute__((address_space(4))) const CFP* InTab;
__device__ __forceinline__ InTab launder_in(InTab p) { asm volatile("" : "+s"(p)); return p; }
#define INP(k) (launder_in(F.in)[k])
struct Frame {
    LAS unsigned char* lds; volatile LAS unsigned* MISC; gu32* ctl;
    int tid, lane, wave, vcu, G;
    InTab in; float* out; unsigned char* ws;
};

__device__ __forceinline__ void p0_transpose_item(const float* W, int K, int N, bf16* WT, int row_off, const float* gk, LAS float* scr, int item, int lane) {
    const int nblk = N / 32, kb = item / nblk, nb = item % nblk, k0 = 64 * kb, n0 = 32 * nb;
#pragma unroll 8
    for (int i = 0; i < 32; ++i) { const int kk = 2 * i + (lane >> 5); float v = W[(size_t)(k0 + kk) * N + n0 + (lane & 31)]; if (gk) v *= gk[k0 + kk]; scr[kk * 33 + (lane & 31)] = v; }
    LDS_WAIT(); asm volatile("" ::: "memory");
    const int c = lane & 7;
#pragma unroll
    for (int j = 0; j < 4; ++j) { const int n = (lane >> 3) + 8 * j; const LAS float* s = scr + (8 * c) * 33 + n;
        v4u o; o.x = pk2(s[0 * 33], s[1 * 33]); o.y = pk2(s[2 * 33], s[3 * 33]); o.z = pk2(s[4 * 33], s[5 * 33]); o.w = pk2(s[6 * 33], s[7 * 33]);
        *(GAS v4u*)(WT + (size_t)(row_off + n0 + n) * K + k0 + 8 * c) = o; }
    LDS_WAIT(); asm volatile("" ::: "memory");
}
__device__ __forceinline__ void rms_row_to_bf16(const float* xrow, const float* g, bf16* orow, int lane) {
    const GAS f32x4* xr = (const GAS f32x4*)xrow + lane; const GAS f32x4* gr = (const GAS f32x4*)g + lane;
    f32x4 v[4]; float s = 0.f;
#pragma unroll
    for (int j = 0; j < 4; ++j) { v[j] = xr[64 * j]; s += (v[j].x * v[j].x + v[j].y * v[j].y) + (v[j].z * v[j].z + v[j].w * v[j].w); }
    const float rstd = 1.0f / sqrtf(wave_sum(s) * (1.f / 1024.f) + NORM_EPS);
    GAS unsigned long long* o8 = (GAS unsigned long long*)orow + lane;
#pragma unroll
    for (int j = 0; j < 4; ++j) { const f32x4 gg = gr[64 * j];
        o8[64 * j] = (unsigned long long)pk2(v[j].x * rstd * gg.x, v[j].y * rstd * gg.y) | ((unsigned long long)pk2(v[j].z * rstd * gg.z, v[j].w * rstd * gg.w) << 32); }
}
__device__ __forceinline__ void p0_prologue(Frame& F) {
    LAS float* scr = (LAS float*)(F.lds + F.wave * 16384);
    const int gw = F.vcu * NWAVES + F.wave, NGW = F.G * NWAVES;
    unsigned char* ws = F.ws;
    constexpr int I_IN = 16 * 80, I_OUT = 16 * 32, I_CQ = 16 * 16, I_MK = 16 * 16, I_MV = 16 * 16, I_CO = 8 * 32, I_UP = 16 * 128, I_DN = 64 * 32;
    constexpr int NITEMS = I_IN + I_OUT + I_CQ + I_MK + I_MV + I_CO + I_UP + I_DN;
    for (int it = gw; it < NITEMS; it += NGW) {
        int r = it;
        if (r < I_IN) { p0_transpose_item(INP(10), 1024, 2560, (bf16*)(ws + WS_WIN), 0, nullptr, scr, r, F.lane); continue; } r -= I_IN;
        if (r < I_OUT) { p0_transpose_item(INP(24), 1024, 1024, (bf16*)(ws + WS_WOUT), 0, nullptr, scr, r, F.lane); continue; } r -= I_OUT;
        if (r < I_CQ) { p0_transpose_item(INP(27), 1024, 512, (bf16*)(ws + WS_WCQ), 0, INP(25), scr, r, F.lane); continue; } r -= I_CQ;
        if (r < I_MK) { p0_transpose_item(INP(28), 1024, 512, (bf16*)(ws + WS_WMKV), 0, nullptr, scr, r, F.lane); continue; } r -= I_MK;
        if (r < I_MV) { p0_transpose_item(INP(29), 1024, 512, (bf16*)(ws + WS_WMKV), 512, nullptr, scr, r, F.lane); continue; } r -= I_MV;
        if (r < I_CO) { p0_transpose_item(INP(30), 512, 1024, (bf16*)(ws + WS_WCO), 0, nullptr, scr, r, F.lane); continue; } r -= I_CO;
        if (r < I_UP) { p0_transpose_item(INP(32), 1024, 4096, (bf16*)(ws + WS_WUP), 0, INP(31), scr, r, F.lane); continue; } r -= I_UP;
        p0_transpose_item(INP(33), 4096, 1024, (bf16*)(ws + WS_WDN), 0, nullptr, scr, r, F.lane);
    }
    {
        bf16* WL = (bf16*)(ws + WS_WLORA); const float* w2 = INP(15); const float* a2 = INP(17); const float* g2 = INP(18);
        const int gt = F.vcu * NTHR + F.tid, NGT = F.G * NTHR;
        for (int idx = gt; idx < 1536 * 256; idx += NGT) {
            const int n = idx >> 8, k = idx & 255; float v = 0.f;
            if (n < 512) { if (k < 64) v = w2[k * 512 + n]; }
            else if (n < 1024) { if (k >= 64 && k < 128) v = a2[(k - 64) * 512 + (n - 512)]; }
            else { if (k >= 128) v = g2[(k - 128) * 512 + (n - 1024)]; }
            WL[idx] = (bf16)f2bf(v);
        }
        const f32x4* ck = (const f32x4*)INP(5); const f32x4* cv = (const f32x4*)INP(6);
        u32x2* mk = (u32x2*)((bf16*)(ws + WS_MKB) + 4 * 256 * 512); u32x2* mv = (u32x2*)((bf16*)(ws + WS_MVB) + 4 * 256 * 512);
        for (int idx = gt; idx < 8 * 256 * 512 / 4; idx += NGT) {
            const f32x4 a = ck[idx], b = cv[idx];
            mk[idx] = (u32x2){pk2(a.x, a.y), pk2(a.z, a.w)}; mv[idx] = (u32x2){pk2(b.x, b.y), pk2(b.z, b.w)};
        }
        const f32x4* ak = (const f32x4*)INP(3); const f32x4* av = (const f32x4*)INP(4);
        f32x4* ok = (f32x4*)(F.out + OFF_SK); f32x4* ov = (f32x4*)(F.out + OFF_SV);
        for (int idx = gt; idx < 8 * 96 * 32; idx += NGT) {
            const int b = idx / (96 * 32), rem = idx % (96 * 32);
            ok[b * 128 * 32 + rem] = ak[b * 128 * 32 + 32 * 32 + rem]; ov[b * 128 * 32 + rem] = av[b * 128 * 32 + 32 * 32 + rem];
        }
    }
    for (int m = gw; m < MALL + 1024; m += NGW) {
        if (m < MALL) { const float* xr = m < MP ? INP(0) + (size_t)m * DM : INP(1) + (size_t)(m - MP) * DM; rms_row_to_bf16(xr, INP(9), (bf16*)(ws + WS_XN) + (size_t)m * DM, F.lane); }
        else { const int r = m - MALL; rms_row_to_bf16(INP(2) + (size_t)r * DM, INP(26), (bf16*)(ws + WS_MN) + (size_t)r * DM, F.lane); }
    }
}

#define EPI_ROWS_BEGIN _Pragma("unroll") for (int ai = 0; ai < NAI; ++ai) _Pragma("unroll") for (int m = 0; m < 4; ++m) { const int row = row0 + ai * 128 + m * 16;
#define EPI_ROWS_END }
#define EPI_PG8_CALL __device__ __forceinline__ void operator()(const f32x4 (&acc)[2][2][4][2], const pg8::Unit& u, int wr, int wc, int fr, int fq) const { \
        this->template run<2, 128>(acc, u.pm * 256 + wr * 64 + fr, u.pn * 256 + wc * 32 + 8 * fq, u.pn * 4 + wc, fq); }
__device__ __forceinline__ v4u pack8(const f32x4 a, const f32x4 b) { v4u w; w.x = pg8::cvt_pk_bf16(a[0], a[1]); w.y = pg8::cvt_pk_bf16(a[2], a[3]); w.z = pg8::cvt_pk_bf16(b[0], b[1]); w.w = pg8::cvt_pk_bf16(b[2], b[3]); return w; }

struct EpiIn {
    static constexpr bool PERM = true, AFTER_DRAIN = false;
    bf16* QKV; bf16* ZR; float* out;
    EPI_PG8_CALL
    template <int NAI, int BJS> __device__ __forceinline__ void run(const f32x4 (&acc)[2][2][4][2], int row0, int colt, int slot, int fq) const {
        const int pn = colt >> 8;
        EPI_ROWS_BEGIN
#pragma unroll
            for (int bj = 0; bj < 2; ++bj) { const int col = colt + bj * BJS; const f32x4 v0 = acc[ai][bj][m][0], v1 = acc[ai][bj][m][1];
                const v4u w = pack8(v0, v1);
                if (pn < 3) *(v4u*)(QKV + (size_t)row * NQKV + col) = w; else *(v4u*)(ZR + (size_t)row * NZR + (col - NQKV)) = w;
                float* dst = nullptr;
                if (pn == 2) { const int cc = col - 512, kv = cc >> 7, c7 = cc & 127;
                    if (row < MP) { const int t = row & 4095; if (t >= 3968) dst = out + (kv ? OFF_PV : OFF_PK) + ((size_t)((row >> 12) * 128 + (t - 3968))) * 128 + c7; }
                    else { const int rs = row - MP; dst = out + (kv ? OFF_SV : OFF_SK) + ((size_t)((rs >> 5) * 128 + 96 + (rs & 31))) * 128 + c7; } }
                else if (pn >= 3) { const int zc = col - NQKV;
                    if (row < MP) { if ((row & 4095) == 4095) dst = out + OFF_PSH + (size_t)(row >> 12) * NZR + zc; }
                    else { const int rs = row - MP; if ((rs & 31) == 31) dst = out + OFF_SSH + (size_t)(rs >> 5) * NZR + zc; } }
                if (dst) { *(f32x4*)dst = v0; *(f32x4*)(dst + 4) = v1; } }
        EPI_ROWS_END
    }
};
struct EpiMemKV {
    static constexpr bool PERM = true, AFTER_DRAIN = false;
    bf16* MKB; bf16* MVB; float* out;
    EPI_PG8_CALL
    template <int NAI, int BJS> __device__ __forceinline__ void run(const f32x4 (&acc)[2][2][4][2], int row0, int colt, int slot, int fq) const {
        EPI_ROWS_BEGIN
#pragma unroll
            for (int bj = 0; bj < 2; ++bj) { const int col = colt + bj * BJS; const f32x4 v0 = acc[ai][bj][m][0], v1 = acc[ai][bj][m][1];
                const int kv = col >> 9, c = col & 511;
                float* dst = out + (kv ? OFF_PMV : OFF_PMK) + (size_t)row * 512 + c; *(f32x4*)dst = v0; *(f32x4*)(dst + 4) = v1;
                *(v4u*)((kv ? MVB : MKB) + (size_t)row * 512 + c) = pack8(v0, v1); }
        EPI_ROWS_END
    }
};
struct EpiLora {
    static constexpr bool PERM = true, AFTER_DRAIN = false;
    float* LW; bf16* AH; bf16* Gg; const float* w0; const float* a0;
    EPI_PG8_CALL
    template <int NAI, int BJS> __device__ __forceinline__ void run(const f32x4 (&acc)[2][2][4][2], int row0, int colt, int slot, int fq) const {
        const int sel = colt >> 9;
        const float* bias = sel == 0 ? w0 : a0; const float mul = sel == 0 ? -0.6065306597f : 1.0f;
        EPI_ROWS_BEGIN
#pragma unroll
            for (int bj = 0; bj < 2; ++bj) { const int c = (colt + bj * BJS) & 511; f32x4 v0 = acc[ai][bj][m][0], v1 = acc[ai][bj][m][1];
                if (sel < 2) {
#pragma unroll
                    for (int e = 0; e < 4; ++e) { v0[e] = mul * sigmoidf_(v0[e] + bias[c + e]); v1[e] = mul * sigmoidf_(v1[e] + bias[c + 4 + e]); } }
                if (sel == 0) { float* dst = LW + (size_t)row * 512 + c; *(f32x4*)dst = v0; *(f32x4*)(dst + 4) = v1; }
                else *(v4u*)((sel == 1 ? AH : Gg) + (size_t)row * 512 + c) = pack8(v0, v1); }
        EPI_ROWS_END
    }
};
struct EpiRes {
    static constexpr bool PERM = true, AFTER_DRAIN = false;
    const float* resP; const float* resS; float* out; bf16* XB; float* PART;
    EPI_PG8_CALL
    template <int NAI, int BJS> __device__ __forceinline__ void run(const f32x4 (&acc)[2][2][4][2], int row0, int colt, int slot, int fq) const {
        EPI_ROWS_BEGIN
            const float* rp = row < MP ? resP + (size_t)row * DM : resS + (size_t)(row - MP) * DM; float ss = 0.f;
#pragma unroll
            for (int bj = 0; bj < 2; ++bj) { const int col = colt + bj * BJS;
                const f32x4 v0 = acc[ai][bj][m][0] + *(const f32x4*)(rp + col), v1 = acc[ai][bj][m][1] + *(const f32x4*)(rp + col + 4);
                float* dst = out + (size_t)row * DM + col; *(f32x4*)dst = v0; *(f32x4*)(dst + 4) = v1;
                if (XB) *(v4u*)(XB + (size_t)row * DM + col) = pack8(v0, v1);
                ss += (v0[0] * v0[0] + v0[1] * v0[1]) + (v0[2] * v0[2] + v0[3] * v0[3]) + (v1[0] * v1[0] + v1[1] * v1[1]) + (v1[2] * v1[2] + v1[3] * v1[3]); }
            ss += __shfl_xor(ss, 16); ss += __shfl_xor(ss, 32);
            if (fq == 0) PART[(size_t)row * 16 + slot] = ss;
        EPI_ROWS_END
    }
};
template <int ACT  > struct EpiNormBf16 {
    static constexpr bool PERM = true, AFTER_DRAIN = false;
    bf16* O; int ldc; const float* PART; float scale;
    EPI_PG8_CALL
    template <int NAI, int BJS> __device__ __forceinline__ void run(const f32x4 (&acc)[2][2][4][2], int row0, int colt, int slot, int fq) const {
        EPI_ROWS_BEGIN
            const f32x4 pp = *(const f32x4*)(PART + (size_t)row * 16 + 4 * fq); float ss = (pp[0] + pp[1]) + (pp[2] + pp[3]);
            ss += __shfl_xor(ss, 16); ss += __shfl_xor(ss, 32);
            const float rs = scale / sqrtf(ss * (1.f / 1024.f) + NORM_EPS);
#pragma unroll
            for (int bj = 0; bj < 2; ++bj) { const int col = colt + bj * BJS; f32x4 v0 = acc[ai][bj][m][0] * rs, v1 = acc[ai][bj][m][1] * rs;
                if (ACT == 1) {
#pragma unroll
                    for (int e = 0; e < 4; ++e) { const float a = fmaxf(v0[e], 0.f), b = fmaxf(v1[e], 0.f); v0[e] = a * a; v1[e] = b * b; } }
                *(v4u*)(O + (size_t)row * ldc + col) = pack8(v0, v1); }
        EPI_ROWS_END
    }
};

template <class Epi> __device__ __forceinline__ void small_gemm(Frame& F, const bf16* A, const bf16* Bt, int K, int N, const Epi& E) {
    const int ntile = 4 * (N / 64), lane = F.lane, wave = F.wave, fr = lane & 15, fq = lane >> 4;
    const int bx = (int)blockIdx.x;
    LAS f32x4* red = (LAS f32x4*)F.lds;
    for (int t = F.G - 1 - bx; t < ntile; t += F.G) {
        const int rowbase = MP + 64 * (t & 3), colbase = 64 * (t >> 2);
        f32x4 acc[2][2][4][2];
#pragma unroll
        for (int bj = 0; bj < 2; ++bj)
#pragma unroll
            for (int m = 0; m < 4; ++m)
#pragma unroll
                for (int n = 0; n < 2; ++n) { acc[0][bj][m][n] = (f32x4){0.f, 0.f, 0.f, 0.f}; acc[1][bj][m][n] = (f32x4){0.f, 0.f, 0.f, 0.f}; }
        const int kslice = K >> 3, kbeg = wave * kslice;
        const bf16* ap = A + (size_t)(rowbase + fr) * K + kbeg + 8 * fq;
        const bf16* bp = Bt + (size_t)(colbase + 8 * (fr >> 2) + (fr & 3)) * K + kbeg + 8 * fq;
#pragma unroll 2
        for (int k0 = 0; k0 < kslice; k0 += 32) {
            bf16x8 af[4], wf[2][2];
#pragma unroll
            for (int m = 0; m < 4; ++m) af[m] = *(const bf16x8*)(ap + (size_t)(16 * m) * K + k0);
#pragma unroll
            for (int bj = 0; bj < 2; ++bj)
#pragma unroll
                for (int n = 0; n < 2; ++n) wf[bj][n] = *(const bf16x8*)(bp + (size_t)(32 * bj + 4 * n) * K + k0);
#pragma unroll
            for (int bj = 0; bj < 2; ++bj)
#pragma unroll
                for (int m = 0; m < 4; ++m)
#pragma unroll
                    for (int n = 0; n < 2; ++n) acc[0][bj][m][n] = __builtin_amdgcn_mfma_f32_16x16x32_bf16(wf[bj][n], af[m], acc[0][bj][m][n], 0, 0, 0);
        }
#pragma unroll
        for (int step = 4; step >= 1; step >>= 1) {
            __syncthreads();
            if (wave >= step && wave < 2 * step) {
#pragma unroll
                for (int bj = 0; bj < 2; ++bj)
#pragma unroll
                    for (int m = 0; m < 4; ++m)
#pragma unroll
                        for (int n = 0; n < 2; ++n) red[((wave - step) * 16 + (bj * 8 + m * 2 + n)) * 64 + lane] = acc[0][bj][m][n]; }
            __syncthreads();
            if (wave < step) {
#pragma unroll
                for (int bj = 0; bj < 2; ++bj)
#pragma unroll
                    for (int m = 0; m < 4; ++m)
#pragma unroll
                        for (int n = 0; n < 2; ++n) acc[0][bj][m][n] += red[(wave * 16 + (bj * 8 + m * 2 + n)) * 64 + lane]; }
        }
        if (wave == 0) E.template run<1, 32>(acc, rowbase + fr, colbase + 8 * fq, colbase >> 6, fq);
    }
    __syncthreads();
}

__device__ __forceinline__ void p2_prep(Frame& F) {
    const int gw = F.vcu * NWAVES + F.wave, NGW = F.G * NWAVES;
    const bf16* ZR = (const bf16*)(F.ws + WS_ZR); bf16* RKV = (bf16*)(F.ws + WS_RKV); bf16* AP = (bf16*)(F.ws + WS_AP);
    const float* mu = INP(13); const float* sshift = INP(7);
    for (int m = gw; m < MALL; m += NGW) {
        const int t = m < MP ? (m & 4095) : ((m - MP) & 31);
        for (int ch = F.lane; ch < NZR / 8; ch += 64) {
            const int col = ch * 8;
            const v4u cu = *(const v4u*)(ZR + (size_t)m * NZR + col);
            float cur[8], prv[8];
#pragma unroll
            for (int e = 0; e < 4; ++e) { cur[2 * e] = __uint_as_float(cu[e] << 16); cur[2 * e + 1] = __uint_as_float(cu[e] & 0xffff0000u); }
            if (t > 0) { const v4u pu = *(const v4u*)(ZR + (size_t)(m - 1) * NZR + col);
#pragma unroll
                for (int e = 0; e < 4; ++e) { prv[2 * e] = __uint_as_float(pu[e] << 16); prv[2 * e + 1] = __uint_as_float(pu[e] & 0xffff0000u); } }
            else if (m >= MP) { const float* sp = sshift + (size_t)((m - MP) >> 5) * NZR + col;
#pragma unroll
                for (int e = 0; e < 8; ++e) prv[e] = sp[e]; }
            else {
#pragma unroll
                for (int e = 0; e < 8; ++e) prv[e] = 0.f; }
            float zs[8];
#pragma unroll
            for (int e = 0; e < 8; ++e) zs[e] = cur[e] + (prv[e] - cur[e]) * mu[col + e];
            if (col >= 1536) {
                if (col < 1600) {
#pragma unroll
                    for (int e = 0; e < 8; ++e) zs[e] = tanhf(zs[e]); }
                else if (col >= 1664) {
#pragma unroll
                    for (int e = 0; e < 8; ++e) zs[e] = sigmoidf_(zs[e]); }
            }
            v4u w; w.x = pk2(zs[0], zs[1]); w.y = pk2(zs[2], zs[3]); w.z = pk2(zs[4], zs[5]); w.w = pk2(zs[6], zs[7]);
            if (col < 1536) *(v4u*)(RKV + (size_t)m * 1536 + col) = w; else *(v4u*)(AP + (size_t)m * 256 + (col - 1536)) = w;
        }
    }
}

constexpr int SC_TT = 32;
constexpr int SC_BUF_FLOATS = 6 * SC_TT * 64;
constexpr int SC_LC = 1024, SC_NPJ = 224, SC_NSJ = 64;
__device__ __forceinline__ float allreduce16(float v) {
    v += __int_as_float(__builtin_amdgcn_update_dpp(0, __float_as_int(v), 0xB1, 0xf, 0xf, false));
    v += __int_as_float(__builtin_amdgcn_update_dpp(0, __float_as_int(v), 0x4E, 0xf, 0xf, false));
    v += __int_as_float(__builtin_amdgcn_update_dpp(0, __float_as_int(v), 0x141, 0xf, 0xf, false));
    v += __int_as_float(__builtin_amdgcn_update_dpp(0, __float_as_int(v), 0x140, 0xf, 0xf, false));
    return v;
}
__device__ __forceinline__ float wave_sum_fast(float v) {
    const int a = __float_as_int(allreduce16(v));
    return (__int_as_float(__builtin_amdgcn_readlane(a, 0)) + __int_as_float(__builtin_amdgcn_readlane(a, 16))) + (__int_as_float(__builtin_amdgcn_readlane(a, 32)) + __int_as_float(__builtin_amdgcn_readlane(a, 48)));
}
__device__ __forceinline__ void p4_scan_job(Frame& F, int job) {
    const bool prompt = job < SC_NPJ; int bh, c, kind;
    if (prompt) { bh = job / 7; const int r = job - 7 * bh; kind = r >= 4 ? 1 : 0; c = kind ? r - 3 : r; } else { bh = job - SC_NPJ; c = 0; kind = 0; }
    const int b = bh >> 3, h = bh & 7, T = prompt ? SC_LC : 32; const int m0 = prompt ? b * 4096 + c * SC_LC : MP + b * 32;
    const bf16* RKV = (const bf16*)(F.ws + WS_RKV); const float* LW = (const float*)(F.ws + WS_LW); const bf16* AH = (const bf16*)(F.ws + WS_AH);
    float* BON = (float*)(F.ws + WS_BON);
    float* Yo = kind ? F.out + (size_t)MALL * 512 : F.out;
    LAS float* L = (LAS float*)F.lds;
    const int lane = F.lane, wave = F.wave, hc = h * 64 + lane;
    const float kkw = INP(19)[hc], kaw = INP(20)[hc], rkw = INP(21)[hc];
    const int rs = lane >> 4, jq = lane & 15, i0 = 8 * wave + rs, i1 = i0 + 4;
    float S0 = 0.f, S1 = 0.f, S2 = 0.f, S3 = 0.f, U0 = 0.f, U1 = 0.f, U2 = 0.f, U3 = 0.f;
    if (kind) { S0 = (4 * jq + 0 == i0) ? 1.f : 0.f; S1 = (4 * jq + 1 == i0) ? 1.f : 0.f; S2 = (4 * jq + 2 == i0) ? 1.f : 0.f; S3 = (4 * jq + 3 == i0) ? 1.f : 0.f;
                U0 = (4 * jq + 0 == i1) ? 1.f : 0.f; U1 = (4 * jq + 1 == i1) ? 1.f : 0.f; U2 = (4 * jq + 2 == i1) ? 1.f : 0.f; U3 = (4 * jq + 3 == i1) ? 1.f : 0.f; }
    else if (!prompt) { const float* st = INP(8) + ((size_t)(bh * 64)) * 64 + 4 * jq; const f32x4 s = *(const f32x4*)(st + (size_t)i0 * 64), u = *(const f32x4*)(st + (size_t)i1 * 64);
                S0 = s[0]; S1 = s[1]; S2 = s[2]; S3 = s[3]; U0 = u[0]; U1 = u[1]; U2 = u[2]; U3 = u[3]; }
    const int ntiles = T / SC_TT;
    float gr[4], gk[4], gv[4], gl[4], ga[4];
#define SC_LOAD(tile) do { _Pragma("unroll") for (int q = 0; q < 4; ++q) { const size_t mm = (size_t)(m0 + (tile) * SC_TT + 4 * wave + q); \
        gr[q] = bf2f(RKV[mm * 1536 + hc]); gk[q] = bf2f(RKV[mm * 1536 + 512 + hc]); gv[q] = bf2f(RKV[mm * 1536 + 1024 + hc]); gl[q] = LW[mm * 512 + hc]; ga[q] = bf2f(AH[mm * 512 + hc]); } } while (0)
#define SC_DERIVE(tile, buf) do { LAS float* Lb = L + (buf) * SC_BUF_FLOATS; _Pragma("unroll") for (int q = 0; q < 4; ++q) { const int s = 4 * wave + q; \
        float kk = gk[q] * kkw; const float n2 = wave_sum_fast(kk * kk); kk = kk / fmaxf(sqrtf(n2), 1e-12f); \
        const float kp = gk[q] * (1.0f + (ga[q] - 1.0f) * kaw); const float bon = wave_sum_fast(gr[q] * kp * rkw); \
        Lb[s * 64 + lane] = __expf(gl[q]); Lb[2048 + s * 64 + lane] = -kk; Lb[4096 + s * 64 + lane] = kk * ga[q]; Lb[6144 + s * 64 + lane] = kp; Lb[8192 + s * 64 + lane] = gr[q]; \
        Lb[10240 + s * 64 + lane] = kind ? 0.f : gv[q]; \
        if (kind == 0 && lane == 0) BON[(size_t)(m0 + (tile) * SC_TT + s) * 8 + h] = bon; } } while (0)
    SC_LOAD(0); SC_DERIVE(0, 0);
    __syncthreads();
#define SC_LD(dst, s_) do { const LAS float* q_ = Lb + (s_) * 64 + 4 * jq; dst##w = *(const LAS f32x4*)q_; dst##a = *(const LAS f32x4*)(q_ + 2048); dst##b = *(const LAS f32x4*)(q_ + 4096); \
        dst##k = *(const LAS f32x4*)(q_ + 6144); dst##r = *(const LAS f32x4*)(q_ + 8192); dst##v = Lb[10240 + (s_) * 64 + i0]; dst##u = Lb[10240 + (s_) * 64 + i1]; } while (0)
#define SC_STEP(src, s_) do { \
        const float p_ = (S0 * src##a[0] + S1 * src##a[1]) + (S2 * src##a[2] + S3 * src##a[3]); \
        const float q_ = (U0 * src##a[0] + U1 * src##a[1]) + (U2 * src##a[2] + U3 * src##a[3]); \
        const float sa_ = allreduce16(p_), ua_ = allreduce16(q_); \
        S0 = S0 * src##w[0] + (sa_ * src##b[0] + src##v * src##k[0]); S1 = S1 * src##w[1] + (sa_ * src##b[1] + src##v * src##k[1]); \
        S2 = S2 * src##w[2] + (sa_ * src##b[2] + src##v * src##k[2]); S3 = S3 * src##w[3] + (sa_ * src##b[3] + src##v * src##k[3]); \
        U0 = U0 * src##w[0] + (ua_ * src##b[0] + src##u * src##k[0]); U1 = U1 * src##w[1] + (ua_ * src##b[1] + src##u * src##k[1]); \
        U2 = U2 * src##w[2] + (ua_ * src##b[2] + src##u * src##k[2]); U3 = U3 * src##w[3] + (ua_ * src##b[3] + src##u * src##k[3]); \
        const float y_ = allreduce16((S0 * src##r[0] + S1 * src##r[1]) + (S2 * src##r[2] + S3 * src##r[3])); \
        const float z_ = allreduce16((U0 * src##r[0] + U1 * src##r[1]) + (U2 * src##r[2] + U3 * src##r[3])); \
        ykeep = (jq == ((s_) & 15)) ? y_ : ykeep; zkeep = (jq == ((s_) & 15)) ? z_ : zkeep; } while (0)
    for (int tile = 0; tile < ntiles; ++tile) {
        const bool more = tile + 1 < ntiles;
        if (more) SC_LOAD(tile + 1);
        const LAS float* Lb = L + (tile & 1) * SC_BUF_FLOATS;
        f32x4 Aw, Aa, Ab, Ak, Ar, Bw, Ba, Bb, Bk, Br; float Av, Au, Bv, Bu; float ykeep = 0.f, zkeep = 0.f;
        SC_LD(A, 0);
#pragma unroll
        for (int s = 0; s < SC_TT; s += 2) {
            SC_LD(B, s + 1);
            SC_STEP(A, s);
            if (s + 2 < SC_TT) SC_LD(A, s + 2);
            SC_STEP(B, s + 1);
            if ((s & 15) == 14) { float* yp = Yo + (size_t)(m0 + tile * SC_TT + (s & 16) + jq) * 512 + h * 64; yp[i0] = ykeep; yp[i1] = zkeep; }
        }
        if (more) SC_DERIVE(tile + 1, (tile + 1) & 1);
        __syncthreads();
    }
#undef SC_LD
#undef SC_STEP
#undef SC_LOAD
#undef SC_DERIVE
    float* so;
    if (prompt) so = (float*)(F.ws + (kind ? WS_GB : WS_HB)) + ((size_t)(bh * 4 + c)) * 4096; else so = F.out + OFF_SWKV + (size_t)bh * 4096;
    *(f32x4*)(so + (size_t)i0 * 64 + 4 * jq) = (f32x4){S0, S1, S2, S3}; *(f32x4*)(so + (size_t)i1 * 64 + 4 * jq) = (f32x4){U0, U1, U2, U3};
}
constexpr int P5_SSTR = 65;
__device__ __forceinline__ void p5_chain_step(LAS float* Sb, LAS float* Gb, const float* Gg, const float* Hg, int tid) {
    __syncthreads();
    for (int idx = tid; idx < 4096; idx += NTHR) Gb[(idx >> 6) * P5_SSTR + (idx & 63)] = Gg[idx];
    __syncthreads();
    const int i = tid >> 3, jb = (tid & 7) * 8; float acc[8];
#pragma unroll
    for (int e = 0; e < 8; ++e) acc[e] = Hg[i * 64 + jb + e];
    for (int jp = 0; jp < 64; ++jp) { const float s = Sb[i * P5_SSTR + jp];
#pragma unroll
        for (int e = 0; e < 8; ++e) acc[e] += s * Gb[jp * P5_SSTR + jb + e]; }
    __syncthreads();
#pragma unroll
    for (int e = 0; e < 8; ++e) Sb[i * P5_SSTR + jb + e] = acc[e];
}
__device__ __forceinline__ void p5_job(Frame& F, int job) {
    const float* Yraw = F.out; const float* QB = F.out + (size_t)MALL * 512; const float* BON = (const float*)(F.ws + WS_BON);
    const bf16* RKV = (const bf16*)(F.ws + WS_RKV); const bf16* Gg = (const bf16*)(F.ws + WS_G); bf16* MIX = (bf16*)(F.ws + WS_XN);
    const float* GB = (const float*)(F.ws + WS_GB); const float* HB = (const float*)(F.ws + WS_HB);
    LAS float* Sb = (LAS float*)F.lds; LAS float* Gb = Sb + 64 * P5_SSTR;
    const bool prompt = job < 256; int bh, c, half;
    if (prompt) { bh = job >> 3; c = (job >> 1) & 3; half = job & 1; } else { bh = job - 256; c = 0; half = 0; }
    const int b = bh >> 3, h = bh & 7, lane = F.lane, hc = h * 64 + lane;
    float srow[64];
    if (prompt && c > 0) {
        __syncthreads();
        for (int idx = F.tid; idx < 4096; idx += NTHR) Sb[(idx >> 6) * P5_SSTR + (idx & 63)] = HB[(size_t)(bh * 4) * 4096 + idx];
        for (int cc = 1; cc < c; ++cc) p5_chain_step(Sb, Gb, GB + (size_t)(bh * 4 + cc) * 4096, HB + (size_t)(bh * 4 + cc) * 4096, F.tid);
        __syncthreads();
#pragma unroll
        for (int j = 0; j < 64; ++j) srow[j] = Sb[lane * P5_SSTR + j];
        if (c == 3 && half == 0) {
            p5_chain_step(Sb, Gb, GB + (size_t)(bh * 4 + 3) * 4096, HB + (size_t)(bh * 4 + 3) * 4096, F.tid);
            __syncthreads();
            for (int idx = F.tid; idx < 4096; idx += NTHR) F.out[OFF_PWKV + (size_t)bh * 4096 + idx] = Sb[(idx >> 6) * P5_SSTR + (idx & 63)];
        }
    } else {
#pragma unroll
        for (int j = 0; j < 64; ++j) srow[j] = 0.f;
    }
    const int ntok = prompt ? 512 : 32, mbase = prompt ? b * 4096 + c * 1024 + half * 512 : MP + b * 32;
    const float lnw = INP(22)[hc], lnb = INP(23)[hc];
    for (int tt = F.wave; tt < ntok; tt += NWAVES) {
        const int m = mbase + tt;
        float y = Yraw[(size_t)m * 512 + hc];
        if (prompt && c > 0) { const int qv = __float_as_int(QB[(size_t)m * 512 + hc]);
#pragma unroll
            for (int j = 0; j < 64; ++j) y += srow[j] * __int_as_float(__builtin_amdgcn_readlane(qv, j)); }
        const float mean = wave_sum_fast(y) * (1.f / 64.f); const float d = y - mean; const float var = wave_sum_fast(d * d) * (1.f / 64.f);
        float o = d * (1.0f / sqrtf(var + GN_EPS)) * lnw + lnb;
        o += BON[(size_t)m * 8 + h] * bf2f(RKV[(size_t)m * 1536 + 1024 + hc]);
        o *= bf2f(Gg[(size_t)m * 512 + hc]);
        MIX[(size_t)m * DM + 512 + hc] = (bf16)f2bf(o);
    }
}
template <int D, int G, int KSTR, int VSTR, class ScoreFn>
__device__ __forceinline__ void attn_group(const LAS unsigned char* Kl, const LAS unsigned char* Vl, const bf16x8 (&qf)[D / 16], f32x16 (&o)[D / 32], float& mrun, float& lrun, int lane, const ScoreFn& sf) {
    const int kr = lane & 31, hh = lane >> 5;
    f32x16 s[G];
#pragma unroll
    for (int kb = 0; kb < G; ++kb) {
#pragma unroll
        for (int e = 0; e < 16; ++e) s[kb][e] = 0.f;
#pragma unroll
        for (int ks = 0; ks < D / 16; ++ks) { const bf16x8 kf = *(const LAS bf16x8*)(Kl + (kb * 32 + kr) * KSTR + (ks * 16 + hh * 8) * 2);
            s[kb] = __builtin_amdgcn_mfma_f32_32x32x16_bf16(kf, qf[ks], s[kb], 0, 0, 0); }
    }
    float gmax = -INFINITY;
#pragma unroll
    for (int kb = 0; kb < G; ++kb)
#pragma unroll
        for (int e = 0; e < 16; ++e) { const float v = sf(kb, e, s[kb][e]); s[kb][e] = v; gmax = fmaxf(gmax, v); }
    gmax = fmaxf(gmax, __shfl_xor(gmax, 32));
    const float mn = fmaxf(mrun, gmax); const float alpha = __builtin_amdgcn_exp2f(mrun - mn); mrun = mn;
    float ps = 0.f;
#pragma unroll
    for (int kb = 0; kb < G; ++kb)
#pragma unroll
        for (int e = 0; e < 16; ++e) { const float p = __builtin_amdgcn_exp2f(s[kb][e] - mn); s[kb][e] = p; ps += p; }
    ps += __shfl_xor(ps, 32);
    lrun = lrun * alpha + ps;
#pragma unroll
    for (int db = 0; db < D / 32; ++db)
#pragma unroll
        for (int e = 0; e < 16; ++e) o[db][e] *= alpha;
    const int q4 = (lane & 15) >> 2, p4 = lane & 3, g16 = (lane >> 4) & 1;
#pragma unroll
    for (int kb = 0; kb < G; ++kb)
#pragma unroll
        for (int s2 = 0; s2 < 2; ++s2) {
            v4u pw; pw.x = pg8::cvt_pk_bf16(s[kb][8 * s2 + 0], s[kb][8 * s2 + 1]); pw.y = pg8::cvt_pk_bf16(s[kb][8 * s2 + 2], s[kb][8 * s2 + 3]);
            pw.z = pg8::cvt_pk_bf16(s[kb][8 * s2 + 4], s[kb][8 * s2 + 5]); pw.w = pg8::cvt_pk_bf16(s[kb][8 * s2 + 6], s[kb][8 * s2 + 7]);
            const bf16x8 pf = __builtin_bit_cast(bf16x8, pw);
            const int key0 = kb * 32 + 16 * s2 + 4 * hh;
#pragma unroll
            for (int db = 0; db < D / 32; ++db) {
                const LAS unsigned char* va = Vl + (key0 + q4) * VSTR + (32 * db + 16 * g16 + 4 * p4) * 2;
                const bf16x4 v0 = __builtin_amdgcn_ds_read_tr16_b64_v4i16((LAS bf16x4*)va);
                const bf16x4 v1 = __builtin_amdgcn_ds_read_tr16_b64_v4i16((LAS bf16x4*)(va + 8 * VSTR));
                const bf16x8 vf = __builtin_shufflevector(v0, v1, 0, 1, 2, 3, 4, 5, 6, 7);
                o[db] = __builtin_amdgcn_mfma_f32_32x32x16_bf16(vf, pf, o[db], 0, 0, 0);
            }
        }
}
template <int D> __device__ __forceinline__ void attn_store(const f32x16 (&o)[D / 32], float inv, bf16* orow, int lane) {
    const int hh = lane >> 5;
#pragma unroll
    for (int db = 0; db < D / 32; ++db)
#pragma unroll
        for (int rq = 0; rq < 4; ++rq) {
            u32x2 w; w.x = pg8::cvt_pk_bf16(o[db][4 * rq] * inv, o[db][4 * rq + 1] * inv); w.y = pg8::cvt_pk_bf16(o[db][4 * rq + 2] * inv, o[db][4 * rq + 3] * inv);
            *(u32x2*)(orow + 32 * db + 8 * rq + 4 * hh) = w;
        }
}

constexpr int SWA_KSTR = 144, SWA_VSTR = 192;
constexpr int SWA_K_OFF = 0, SWA_V_OFF = 192 * SWA_KSTR  , SWA_LUT_OFF = SWA_V_OFF + 192 * SWA_VSTR  ;
__device__ __forceinline__ int t5_bucket(int rel) {
    const int n = rel < 0 ? -rel : rel;
    int v = n < 8 ? n : (n < 12 ? 8 : (n < 16 ? 9 : (n < 23 ? 10 : (n < 32 ? 11 : (n < 46 ? 12 : (n < 64 ? 13 : (n < 91 ? 14 : 15)))))));
    return (rel > 0 ? 16 : 0) + v;
}
struct SwaScore { const LAS float* lut; int qi; int hh; int jlo, jhi; float sc2;
    __device__ __forceinline__ float operator()(int kb, int e, float raw) const {
        const int j = kb * 32 + (e & 3) + 8 * (e >> 2) + 4 * hh;
        const float v = raw * sc2 + lut[j - qi + 63];
        return (j >= jlo && j < jhi) ? v : -INFINITY; } };
__device__ __forceinline__ void swa_build_lut(Frame& F) {
    LAS float* lut = (LAS float*)(F.lds + SWA_LUT_OFF); const float* table = INP(12);
    for (int idx = F.tid; idx < 8 * 256; idx += NTHR) { const int h = idx >> 8, x = idx & 255; const int rel = x - 191;
        lut[idx] = x < 255 ? table[t5_bucket(rel) * 8 + h] * LOG2E : 0.f; }
}
__device__ __forceinline__ void swa_unit(Frame& F, int u) {
    const bool prompt = u < 512; int b, c, kvh;
    if (prompt) { b = u >> 7; c = (u >> 1) & 63; kvh = u & 1; } else { b = (u - 512) >> 1; c = 0; kvh = u & 1; }
    const bf16* QKV = (const bf16*)(F.ws + WS_QKV); bf16* MIX = (bf16*)(F.ws + WS_XN);
    LAS unsigned char* Kl = F.lds + SWA_K_OFF; LAS unsigned char* Vl = F.lds + SWA_V_OFF;
    __syncthreads();
    for (int idx = F.tid; idx < 192 * 8; idx += NTHR) {
        const int j = idx >> 3, c8 = idx & 7; v4u kw = (v4u){0u, 0u, 0u, 0u}, vw = (v4u){0u, 0u, 0u, 0u};
        if (prompt) { const int pos = 64 * c - 128 + j;
            if (pos >= 0) { const bf16* src = QKV + (size_t)(b * 4096 + pos) * NQKV + 512 + 64 * kvh + 8 * c8; kw = *(const v4u*)src; vw = *(const v4u*)(src + 128); } }
        else if (j < 128) { const float* sk = INP(3) + ((size_t)(b * 128 + j)) * 128 + 64 * kvh + 8 * c8; const float* sv = INP(4) + ((size_t)(b * 128 + j)) * 128 + 64 * kvh + 8 * c8;
            const f32x4 k0 = *(const f32x4*)sk, k1 = *(const f32x4*)(sk + 4), v0 = *(const f32x4*)sv, v1 = *(const f32x4*)(sv + 4);
            kw = (v4u){pk2(k0[0], k0[1]), pk2(k0[2], k0[3]), pk2(k1[0], k1[1]), pk2(k1[2], k1[3])}; vw = (v4u){pk2(v0[0], v0[1]), pk2(v0[2], v0[3]), pk2(v1[0], v1[1]), pk2(v1[2], v1[3])}; }
        else if (j < 160) { const bf16* src = QKV + (size_t)(MP + b * 32 + (j - 128)) * NQKV + 512 + 64 * kvh + 8 * c8; kw = *(const v4u*)src; vw = *(const v4u*)(src + 128); }
        *(LAS v4u*)(Kl + j * SWA_KSTR + c8 * 16) = kw; *(LAS v4u*)(Vl + j * SWA_VSTR + c8 * 16) = vw;
    }
    __syncthreads();
    const int wave = F.wave, lane = F.lane;
    const bool active = prompt || wave < 4;
    if (active) {
        const int head = 4 * kvh + (prompt ? (wave >> 1) : wave), q0 = prompt ? 32 * (wave & 1) : 0;
        const int mq = (prompt ? b * 4096 + 64 * c : MP + b * 32) + q0 + (lane & 31);
        bf16x8 qf[4];
#pragma unroll
        for (int ks = 0; ks < 4; ++ks) qf[ks] = *(const bf16x8*)(QKV + (size_t)mq * NQKV + head * 64 + ks * 16 + (lane >> 5) * 8);
        f32x16 o[2];
#pragma unroll
        for (int db = 0; db < 2; ++db)
#pragma unroll
            for (int e = 0; e < 16; ++e) o[db][e] = 0.f;
        const float sink2 = INP(11)[head] * LOG2E;
        float mrun = sink2, lrun = 0.f;
        SwaScore sf; sf.lut = (const LAS float*)(F.lds + SWA_LUT_OFF) + head * 256; sf.qi = q0 + (lane & 31); sf.hh = lane >> 5; sf.sc2 = 0.125f * LOG2E;
        if (prompt) { sf.jlo = 128 - 64 * c; sf.jhi = 192; } else { sf.jlo = 0; sf.jhi = 160; }
        attn_group<64, 6, SWA_KSTR, SWA_VSTR>(Kl, Vl, qf, o, mrun, lrun, lane, sf);
        const float den = lrun + __builtin_amdgcn_exp2f(sink2 - mrun);
        attn_store<64>(o, 1.0f / den, MIX + (size_t)mq * DM + head * 64, lane);
    }
}

constexpr int CA_KSTR = 272, CA_VSTR = 320, CA_K_OFF = 0, CA_V_OFF = 128 * CA_KSTR  ;
struct PlainScore { float sc2; __device__ __forceinline__ float operator()(int, int, float raw) const { return raw * sc2; } };
__device__ __forceinline__ void ca_unit(Frame& F, int u) {
    const bool prompt = u < 256; const int hd = u & 3; int mbase, bidx;
    if (prompt) { const int tile = u >> 2; mbase = tile * 256; bidx = tile >> 4; } else { const int b = (u - 256) >> 2; mbase = MP + b * 32; bidx = 4 + b; }
    const bf16* QC = (const bf16*)(F.ws + WS_RKV); bf16* OC = (bf16*)(F.ws + WS_XN);
    const bf16* MKB = (const bf16*)(F.ws + WS_MKB) + (size_t)bidx * 256 * 512 + hd * 128; const bf16* MVB = (const bf16*)(F.ws + WS_MVB) + (size_t)bidx * 256 * 512 + hd * 128;
    LAS unsigned char* Kl = F.lds + CA_K_OFF; LAS unsigned char* Vl = F.lds + CA_V_OFF;
    const int wave = F.wave, lane = F.lane; const bool active = prompt || wave == 0;
    const int mq = mbase + (prompt ? 32 * wave : 0) + (lane & 31);
    bf16x8 qf[8]; f32x16 o[4]; float mrun = -INFINITY, lrun = 0.f;
    if (active) {
#pragma unroll
        for (int ks = 0; ks < 8; ++ks) qf[ks] = *(const bf16x8*)(QC + (size_t)mq * 512 + hd * 128 + ks * 16 + (lane >> 5) * 8);
    }
#pragma unroll
    for (int db = 0; db < 4; ++db)
#pragma unroll
        for (int e = 0; e < 16; ++e) o[db][e] = 0.f;
    PlainScore sf; sf.sc2 = 0.08838834764831845f * LOG2E;
    for (int g = 0; g < 2; ++g) {
        __syncthreads();
        for (int idx = F.tid; idx < 128 * 16; idx += NTHR) { const int j = idx >> 4, c8 = idx & 15;
            *(LAS v4u*)(Kl + j * CA_KSTR + c8 * 16) = *(const v4u*)(MKB + (size_t)(g * 128 + j) * 512 + 8 * c8);
            *(LAS v4u*)(Vl + j * CA_VSTR + c8 * 16) = *(const v4u*)(MVB + (size_t)(g * 128 + j) * 512 + 8 * c8); }
        __syncthreads();
        if (active) attn_group<128, 4, CA_KSTR, CA_VSTR>(Kl, Vl, qf, o, mrun, lrun, lane, sf);
    }
    if (active) attn_store<128>(o, 1.0f / lrun, OC + (size_t)mq * 512 + hd * 128, lane);
}

__device__ __forceinline__ void p11_final(Frame& F) {
    const int gw = F.vcu * NWAVES + F.wave, NGW = F.G * NWAVES; const float* PART = (const float*)(F.ws + WS_PART3); const float* g = INP(34);
    for (int m = gw; m < MALL; m += NGW) {
        const f32x4 p0 = *(const f32x4*)(PART + (size_t)m * 16), p1 = *(const f32x4*)(PART + (size_t)m * 16 + 4), p2 = *(const f32x4*)(PART + (size_t)m * 16 + 8), p3 = *(const f32x4*)(PART + (size_t)m * 16 + 12);
        const float ss = ((p0[0] + p0[1]) + (p0[2] + p0[3])) + ((p1[0] + p1[1]) + (p1[2] + p1[3])) + ((p2[0] + p2[1]) + (p2[2] + p2[3])) + ((p3[0] + p3[1]) + (p3[2] + p3[3]));
        const float rs = 1.0f / sqrtf(ss * (1.f / 1024.f) + NORM_EPS);
        f32x4* xr = (f32x4*)(F.out + (size_t)m * DM) + F.lane; const f32x4* gr = (const f32x4*)g + F.lane;
#pragma unroll
        for (int j = 0; j < 4; ++j) { f32x4 v = xr[64 * j]; const f32x4 gg = gr[64 * j]; v = v * rs; v[0] *= gg[0]; v[1] *= gg[1]; v[2] *= gg[2]; v[3] *= gg[3]; xr[64 * j] = v; }
    }
}

#ifndef PROBE_ATT_REP
#define PROBE_ATT_REP 1
#endif
#ifndef PROBE_SCAN_REP
#define PROBE_SCAN_REP 1
#endif
#ifndef PROBE_PHASE
#define PROBE_PHASE -1
#endif
#ifndef MK_SPLIT
#define MK_SPLIT 0
#endif
constexpr int N_PHASES = 13;
struct Args { const float* in[35]; float* out; unsigned char* ws; int ph_lo, ph_hi; };
static_assert(sizeof(Args) == 35 * 8 + 8 + 8 + 8, "Args has no padding");

__global__ void __launch_bounds__(NTHR, 2) hymba_fwd(Args args) {
    extern __shared__ __attribute__((aligned(16))) unsigned char lds_raw[];
    Frame F;
    F.lds = (LAS unsigned char*)lds_raw; F.MISC = (volatile LAS unsigned*)(F.lds + MISC_OFF);
    F.tid = threadIdx.x; F.lane = F.tid & 63; F.wave = __builtin_amdgcn_readfirstlane(F.tid >> 6);
    F.G = gridDim.x; { const int bx = blockIdx.x; F.vcu = (F.G % 8 == 0) ? (bx % 8) * (F.G / 8) + bx / 8 : bx; }
    F.in = (InTab)__builtin_amdgcn_kernarg_segment_ptr();
    F.out = args.out; F.ws = args.ws; F.ctl = (gu32*)(args.ws + WS_CTL);
    unsigned char* ws = args.ws;
    for (int u = F.tid; u < (LDS_BYTES - LDSCTL_OFF) / 4; u += NTHR) ((LAS unsigned*)(F.lds + LDSCTL_OFF))[u] = 0u;
    __syncthreads();
    XcdBarrier bar; bar.bar = (unsigned*)(F.ctl + CW_BAR); bar.x = 0; bar.st = nullptr;
    const int lo = args.ph_lo, hi = args.ph_hi;
    if (hi - lo > 1) bar = xcd_barrier_post((unsigned*)(F.ctl + CW_BAR), F.MISC + 8);
#define IN(k) (lo <= (k) && (k) < hi)
#define FRESH() do { int t_ = threadIdx.x; asm volatile("" : "+v"(t_)); F.tid = t_; F.lane = t_ & 63; F.wave = __builtin_amdgcn_readfirstlane(t_ >> 6); } while (0)
#define SEAM(k) do { if (IN(k) && IN((k) + 1)) xcd_barrier(bar); } while (0)
    const int bx = (int)blockIdx.x;

    if (IN(0)) { FRESH(); p0_prologue(F); } SEAM(0);
    if (IN(1)) { FRESH();
        { pg8::Gemm g{(const pg8::bf16_t*)(ws + WS_XN), (const pg8::bf16_t*)(ws + WS_WIN), MALL, 2560, 1024}; pg8::StaticOrder S; S.init(MP, 2560, F.G, bx);
          EpiIn E{(bf16*)(ws + WS_QKV), (bf16*)(ws + WS_ZR), F.out};
          pg8::gemm_phase<EpiIn, pg8::StaticOrder, true, true>(F.lds, g, S, E);
          FRESH(); small_gemm(F, g.A, g.Bt, 1024, 2560, E); }
        { pg8::Gemm g{(const pg8::bf16_t*)(ws + WS_MN), (const pg8::bf16_t*)(ws + WS_WMKV), 1024, 1024, 1024}; pg8::StaticOrder S; S.init(1024, 1024, F.G, (bx + 96) % F.G);
          EpiMemKV E{(bf16*)(ws + WS_MKB), (bf16*)(ws + WS_MVB), F.out};
          pg8::gemm_phase<EpiMemKV, pg8::StaticOrder, true, true>(F.lds, g, S, E); }
    } SEAM(1);
    if (IN(2)) { FRESH(); p2_prep(F); } SEAM(2);
    if (IN(3)) { FRESH();
        pg8::Gemm g{(const pg8::bf16_t*)(ws + WS_AP), (const pg8::bf16_t*)(ws + WS_WLORA), MALL, 1536, 256}; pg8::StaticOrder S; S.init(MP, 1536, F.G, bx);
        EpiLora E{(float*)(ws + WS_LW), (bf16*)(ws + WS_AH), (bf16*)(ws + WS_G), INP(14), INP(16)};
        pg8::gemm_phase<EpiLora, pg8::StaticOrder, true, true>(F.lds, g, S, E);
        FRESH(); small_gemm(F, g.A, g.Bt, 256, 1536, E);
    } SEAM(3);
    if (IN(4)) { FRESH();
        for (int rep_ = 0; rep_ < PROBE_SCAN_REP; ++rep_)
            for (int j = F.vcu; j < SC_NPJ + SC_NSJ; j += F.G) { __syncthreads(); p4_scan_job(F, j); }
        { __syncthreads(); swa_build_lut(F);
          const int a0 = (F.vcu + F.G - (SC_NPJ % F.G)) % F.G;
          for (int rep_ = 0; rep_ < PROBE_ATT_REP; ++rep_) for (int u = a0; u < 528; u += F.G) swa_unit(F, u); }
    } SEAM(4);
    if (IN(5)) { FRESH(); for (int j = F.vcu; j < 256 + 64; j += F.G) p5_job(F, j); } SEAM(5);
    if (IN(6)) { FRESH();
        pg8::Gemm g{(const pg8::bf16_t*)(ws + WS_XN), (const pg8::bf16_t*)(ws + WS_WOUT), MALL, 1024, 1024}; pg8::StaticOrder S; S.init(MP, 1024, F.G, bx);
        EpiRes E{INP(0), INP(1), F.out, (bf16*)(ws + WS_XB), (float*)(ws + WS_PART1)};
        pg8::gemm_phase<EpiRes, pg8::StaticOrder, true, true>(F.lds, g, S, E);
        FRESH(); small_gemm(F, g.A, g.Bt, 1024, 1024, E);
    } SEAM(6);
    if (IN(7)) { FRESH();
        pg8::Gemm g{(const pg8::bf16_t*)(ws + WS_XB), (const pg8::bf16_t*)(ws + WS_WCQ), MALL, 512, 1024}; pg8::StaticOrder S; S.init(MP, 512, F.G, bx);
        EpiNormBf16<0> E{(bf16*)(ws + WS_RKV), 512, (const float*)(ws + WS_PART1), 1.0f};
        pg8::gemm_phase<EpiNormBf16<0>, pg8::StaticOrder, true, true>(F.lds, g, S, E);
        FRESH(); small_gemm(F, g.A, g.Bt, 1024, 512, E);
    } SEAM(7);
    if (IN(8)) { FRESH(); for (int u = F.vcu; u < 288; u += F.G) ca_unit(F, u); } SEAM(8);
    if (IN(9)) { FRESH();
        pg8::Gemm g{(const pg8::bf16_t*)(ws + WS_XN), (const pg8::bf16_t*)(ws + WS_WCO), MALL, 1024, 512}; pg8::StaticOrder S; S.init(MP, 1024, F.G, bx);
        EpiRes E{F.out, F.out + (size_t)MP * DM, F.out, (bf16*)(ws + WS_XB), (float*)(ws + WS_PART2)};
        pg8::gemm_phase<EpiRes, pg8::StaticOrder, true, true>(F.lds, g, S, E);
        FRESH(); small_gemm(F, g.A, g.Bt, 512, 1024, E);
    } SEAM(9);
    if (IN(10)) { FRESH();
        pg8::Gemm g{(const pg8::bf16_t*)(ws + WS_XB), (const pg8::bf16_t*)(ws + WS_WUP), MALL, 4096, 1024}; pg8::StaticOrder S; S.init(MP, 4096, F.G, bx);
        EpiNormBf16<1> E{(bf16*)(ws + WS_H), 4096, (const float*)(ws + WS_PART2), 1.0f};
        pg8::gemm_phase<EpiNormBf16<1>, pg8::StaticOrder, true, true>(F.lds, g, S, E);
        FRESH(); small_gemm(F, g.A, g.Bt, 1024, 4096, E);
    } SEAM(10);
    if (IN(11)) { FRESH();
        pg8::Gemm g{(const pg8::bf16_t*)(ws + WS_H), (const pg8::bf16_t*)(ws + WS_WDN), MALL, 1024, 4096}; pg8::StaticOrder S; S.init(MP, 1024, F.G, bx);
        EpiRes E{F.out, F.out + (size_t)MP * DM, F.out, nullptr, (float*)(ws + WS_PART3)};
        pg8::gemm_phase<EpiRes, pg8::StaticOrder, true, true>(F.lds, g, S, E);
        FRESH(); small_gemm(F, g.A, g.Bt, 4096, 1024, E);
    } SEAM(11);
    if (IN(12)) { FRESH(); p11_final(F); }
#undef IN
#undef SEAM
}

extern "C" void kernel_launch(void* const* d_in, const int* in_sizes, int n_in, void* d_out, int out_size, void* d_ws, size_t ws_size, hipStream_t stream) {
    static int grid = 0;
    if (grid == 0) {
        if (n_in != 35 || out_size != (int)OUT_TOTAL || ws_size < WS_END) { fprintf(stderr, "kernel_launch: unexpected shapes: n_in %d out %d ws %zu\n", n_in, out_size, ws_size); grid = -1; return; }
        int dev = 0, cus = 0, per_cu = 0;
        if (hipGetDevice(&dev) != hipSuccess || hipDeviceGetAttribute(&cus, hipDeviceAttributeMultiprocessorCount, dev) != hipSuccess) { grid = -1; return; }
        if (hipFuncSetAttribute((const void*)hymba_fwd, hipFuncAttributeMaxDynamicSharedMemorySize, LDS_BYTES) != hipSuccess) { fprintf(stderr, "kernel_launch: hipFuncSetAttribute failed\n"); grid = -1; return; }
        if (hipOccupancyMaxActiveBlocksPerMultiprocessor(&per_cu, (const void*)hymba_fwd, NTHR, LDS_BYTES) != hipSuccess || per_cu < 1)
            fprintf(stderr, "kernel_launch: occupancy query reports %d workgroups per CU\n", per_cu);
        (void)hipGetLastError();
        grid = cus;
    }
    if (grid < 0) return;
    if (hipMemsetAsync((char*)d_ws + WS_CTL, 0, CTL_ZERO_BYTES, stream) != hipSuccess) { fprintf(stderr, "kernel_launch: memset failed\n"); return; }
    Args a{};
    for (int i = 0; i < 35; ++i) a.in[i] = (const float*)d_in[i];
    a.out = (float*)d_out; a.ws = (unsigned char*)d_ws;
#if MK_SPLIT
    for (int p = 0; p < N_PHASES; ++p) { a.ph_lo = p; a.ph_hi = p + 1; hipLaunchKernelGGL(hymba_fwd, dim3(grid), dim3(NTHR), LDS_BYTES, stream, a); }
#elif PROBE_PHASE >= 0
    a.ph_lo = 0; a.ph_hi = PROBE_PHASE + 1; hipLaunchKernelGGL(hymba_fwd, dim3(grid), dim3(NTHR), LDS_BYTES, stream, a);
    (void)hipMemsetAsync((char*)d_ws + WS_CTL, 0, CTL_ZERO_BYTES, stream);
    a.ph_lo = PROBE_PHASE; a.ph_hi = N_PHASES; hipLaunchKernelGGL(hymba_fwd, dim3(grid), dim3(NTHR), LDS_BYTES, stream, a);
#else
    a.ph_lo = 0; a.ph_hi = N_PHASES; hipLaunchKernelGGL(hymba_fwd, dim3(grid), dim3(NTHR), LDS_BYTES, stream, a);
#endif
    const hipError_t le = hipPeekAtLastError();
    if (le != hipSuccess) fprintf(stderr, "kernel_launch: launch failed: %s\n", hipGetErrorName(le));
}
```

```cpp
#define MK_SPLIT 0
#define PROBE_PHASE -1
#include <hip/hip_runtime.h>
#include <cstdio>
#include <cstdint>
namespace pg8 {
#define PG8_LAS __attribute__((address_space(3)))
typedef unsigned short bf16_t;
typedef short bf16x8 __attribute__((ext_vector_type(8)));
typedef float f32x4 __attribute__((ext_vector_type(4)));
typedef unsigned u32x4 __attribute__((ext_vector_type(4)));
constexpr int BM = 256, BK = 64, HALF = 128, HTB = HALF * BK * 2  , STAGE_BYTES = 8 * HTB, NXCD = 8, WGM = 8;

__host__ __device__ __forceinline__ int lds_byte(int r, int c) { const int st = (r >> 4) * 2 + (c >> 5), rr = r & 15, cc = c & 31, ob = rr * 64 + cc * 2; return st * 1024 + (ob ^ (((ob >> 9) & 1) << 5)); }
__host__ __device__ __forceinline__ void stage_rc(int b, int& R, int& C) { const int st = b / 1024, sb = b % 1024, swz = sb ^ (((sb >> 9) & 1) << 5); R = (st >> 1) * 16 + swz / 64; C = (st & 1) * 32 + (swz % 64) / 2; }
__host__ __device__ __forceinline__ int perm32(int rho) { const int n = rho >> 4, i = rho & 15; return 8 * (i >> 2) + 4 * n + (i & 3); }

struct Unit { int pm, pn; };
struct Gemm { const bf16_t* A; const bf16_t* Bt; int M, N, K; };

struct StaticOrder {
    int nM, nN, nwg, G, c;
    __host__ __device__ void init(int M, int N, int G_, int c_) { nM = M / BM; nN = N / BM; nwg = nM * nN; G = G_; c = c_; }
    __host__ __device__ bool next(int i, Unit& u) const {
        const long L = (long)i * G + c; if (L >= nwg) return false;
        int wgid = (int)L; { const int q = nwg / NXCD, r = nwg % NXCD, xcd = wgid % NXCD, off = wgid / NXCD; wgid = (xcd < r ? xcd * (q + 1) : r * (q + 1) + (xcd - r) * q) + off; }
        const int nig = WGM * nN, gid = wgid / nig, fm = gid * WGM, gsz = (nM - fm) < WGM ? (nM - fm) : WGM;
        u.pm = fm + ((wgid % nig) % gsz); u.pn = (wgid % nig) / gsz; return true;
    }
    __device__ __forceinline__ void a_ready(const Unit&) const {}
    __device__ __forceinline__ void done(const Unit&) const {}
};

typedef float cvt_f32x2 __attribute__((ext_vector_type(2)));
typedef __bf16 cvt_bf16x2 __attribute__((ext_vector_type(2)));
__device__ __forceinline__ unsigned cvt_pk_bf16(float lo, float hi) { const cvt_f32x2 v = {lo, hi}; return __builtin_bit_cast(unsigned, __builtin_convertvector(v, cvt_bf16x2)); }
template <class Epi, class Sched, bool ALIGN_EPI = false, bool SP2 = false>
__device__ __forceinline__ void gemm_phase(PG8_LAS unsigned char* lds, const Gemm g, const Sched& S, const Epi& E) {
    const int tid = threadIdx.x, wid = __builtin_amdgcn_readfirstlane(tid >> 6), lane = tid & 63, wr = wid >> 2, wc = wid & 3, fr = lane & 15, fq = lane >> 4;
    const int K = g.K, nt = K / BK;
    unsigned voffA[2], voffB[2];
#pragma unroll
    for (int i = 0; i < 2; ++i) { int R, C; stage_rc(tid * 16 + i * 8192, R, C); const int Rb = Epi::PERM ? ((R & ~31) + perm32(R & 31)) : R;
        voffA[i] = (unsigned)(R * K + C) * 2u; voffB[i] = (unsigned)(Rb * K + C) * 2u; }
    const size_t kstep = (size_t)(BK * 2);
    const size_t hstep = (size_t)HALF * K * 2;
    const size_t tstep = 2 * hstep;
    const unsigned ldsw = (unsigned)wid * 1024u;
    const int aoff = lds_byte(wr * 64 + fr, fq * 8), boff = lds_byte(wc * 32 + fr, fq * 8);
#define PG8_SA(b, h) (((b) * 2 + (h)) * HTB)
#define PG8_SB(b, h) ((4 + (b) * 2 + (h)) * HTB)
#define PG8_STAGE(bufoff, gbase, voff) do { _Pragma("unroll") for (int _i = 0; _i < 2; ++_i) \
        __builtin_amdgcn_global_load_lds((const unsigned*)((const char*)(gbase) + (voff)[_i]), (PG8_LAS unsigned*)(lds + (bufoff) + ldsw + _i * 8192), 16, 0, 0); } while (0)
#define PG8_LDA(dst, b, h) do { _Pragma("unroll") for (int m = 0; m < 4; ++m) _Pragma("unroll") for (int k = 0; k < 2; ++k) dst[m][k] = *(const PG8_LAS bf16x8*)(lds + PG8_SA(b, h) + aoff + m * 2048 + k * 1024); } while (0)
#define PG8_LDB(dst, b, h) do { _Pragma("unroll") for (int n = 0; n < 2; ++n) _Pragma("unroll") for (int k = 0; k < 2; ++k) dst[n][k] = *(const PG8_LAS bf16x8*)(lds + PG8_SB(b, h) + boff + n * 2048 + k * 1024); } while (0)
#define PG8_MMA(ai, bj, At, Bt) do { __builtin_amdgcn_s_setprio(1); _Pragma("unroll") for (int m = 0; m < 4; ++m) _Pragma("unroll") for (int n = 0; n < 2; ++n) _Pragma("unroll") for (int k = 0; k < 2; ++k) \
        acc[ai][bj][m][n] = __builtin_amdgcn_mfma_f32_16x16x32_bf16(Bt[n][k], At[m][k], acc[ai][bj][m][n], 0, 0, 0); __builtin_amdgcn_s_setprio(0); } while (0)
#define PG8_WAIT_V(n) asm volatile("s_waitcnt vmcnt(" #n ")" ::: "memory")
#define PG8_WAIT_L(n) asm volatile("s_waitcnt lgkmcnt(" #n ")" ::: "memory")
#define PG8_BAR __builtin_amdgcn_s_barrier()
#define PG8_SCHED __builtin_amdgcn_sched_barrier(0)
    Unit cur, nxt; int ui = 0;
    if (!S.next(0, cur)) return;
    f32x4 acc[2][2][4][2];
#pragma unroll
    for (int a = 0; a < 2; ++a)
#pragma unroll
        for (int b = 0; b < 2; ++b)
#pragma unroll
            for (int m = 0; m < 4; ++m)
#pragma unroll
                for (int n = 0; n < 2; ++n) acc[a][b][m][n] = (f32x4){0.f, 0.f, 0.f, 0.f};
    bf16x8 At[4][2], B0[2][2], B1[2][2];
    const char* cA = (const char*)g.A + (size_t)cur.pm * tstep; const char* cB = (const char*)g.Bt + (size_t)cur.pn * tstep;
    S.a_ready(cur);
    if constexpr (SP2) {
        PG8_STAGE(PG8_SB(0, 0), cB, voffB); PG8_STAGE(PG8_SB(0, 1), cB + hstep, voffB); PG8_STAGE(PG8_SA(0, 0), cA, voffA); PG8_STAGE(PG8_SA(0, 1), cA + hstep, voffA);
        if (wr == 1) PG8_BAR;
        PG8_WAIT_V(2); PG8_BAR;
        PG8_STAGE(PG8_SB(1, 0), cB + kstep, voffB); PG8_STAGE(PG8_SA(1, 0), cA + kstep, voffA); PG8_STAGE(PG8_SB(1, 1), cB + hstep + kstep, voffB);
        PG8_WAIT_V(6); PG8_BAR;
    } else {
        PG8_STAGE(PG8_SB(0, 0), cB, voffB); PG8_STAGE(PG8_SA(0, 0), cA, voffA); PG8_STAGE(PG8_SB(0, 1), cB + hstep, voffB); PG8_STAGE(PG8_SA(0, 1), cA + hstep, voffA);
        if (wr == 1) PG8_BAR;
        PG8_WAIT_V(4); PG8_BAR;
        PG8_STAGE(PG8_SB(1, 0), cB + kstep, voffB); PG8_STAGE(PG8_SA(1, 0), cA + kstep, voffA); PG8_STAGE(PG8_SB(1, 1), cB + hstep + kstep, voffB);
        PG8_WAIT_V(6); PG8_BAR;
    }
    for (;;) {
        const bool has_next = S.next(ui + 1, nxt);
        const char* nA = has_next ? (const char*)g.A + (size_t)nxt.pm * tstep : cA; const char* nB = has_next ? (const char*)g.Bt + (size_t)nxt.pn * tstep : cB;
        for (int t = 0; t < nt; t += 2) {
            const bool last = (t == nt - 2);
            const char* a1 = cA + (size_t)(t + 1) * kstep;
            const char* a2 = last ? nA : cA + (size_t)(t + 2) * kstep; const char* b2 = last ? nB : cB + (size_t)(t + 2) * kstep;
            const char* a3 = a2 + kstep; const char* b3 = b2 + kstep;
            if (last && has_next) S.a_ready(nxt);
            if constexpr (SP2) {
            PG8_LDB(B0, 0, 0); PG8_LDB(B1, 0, 1); PG8_SCHED; PG8_LDA(At, 0, 0); PG8_STAGE(PG8_SA(1, 1), a1 + hstep, voffA);
            PG8_WAIT_V(8); PG8_WAIT_L(0); PG8_BAR; PG8_MMA(0, 0, At, B0); PG8_MMA(0, 1, At, B1); PG8_BAR; PG8_SCHED;
            PG8_LDA(At, 0, 1); PG8_STAGE(PG8_SB(0, 0), b2, voffB); PG8_STAGE(PG8_SB(0, 1), b2 + hstep, voffB); PG8_STAGE(PG8_SA(0, 0), a2, voffA);
            PG8_WAIT_V(8); PG8_WAIT_L(0); PG8_BAR; PG8_MMA(1, 0, At, B0); PG8_MMA(1, 1, At, B1); PG8_BAR; PG8_SCHED;
            PG8_LDB(B0, 1, 0); PG8_LDB(B1, 1, 1); PG8_SCHED; PG8_LDA(At, 1, 0); PG8_STAGE(PG8_SA(0, 1), a2 + hstep, voffA);
            PG8_WAIT_V(8); PG8_WAIT_L(0); PG8_BAR; PG8_MMA(0, 0, At, B0); PG8_MMA(0, 1, At, B1); PG8_BAR; PG8_SCHED;
            PG8_LDA(At, 1, 1); PG8_STAGE(PG8_SB(1, 0), b3, voffB); PG8_STAGE(PG8_SB(1, 1), b3 + hstep, voffB); PG8_STAGE(PG8_SA(1, 0), a3, voffA);
            PG8_WAIT_V(8); PG8_WAIT_L(0); PG8_BAR; PG8_MMA(1, 0, At, B0); PG8_MMA(1, 1, At, B1); PG8_BAR; PG8_SCHED;
            } else {
            PG8_LDB(B0, 0, 0); PG8_SCHED; PG8_LDA(At, 0, 0); PG8_STAGE(PG8_SA(1, 1), a1 + hstep, voffA);
            PG8_WAIT_L(8); PG8_BAR; PG8_WAIT_L(0); PG8_MMA(0, 0, At, B0); PG8_BAR; PG8_SCHED;
            PG8_LDB(B1, 0, 1); PG8_STAGE(PG8_SB(0, 0), b2, voffB);
            PG8_BAR; PG8_WAIT_L(0); PG8_MMA(0, 1, At, B1); PG8_BAR;
            PG8_LDA(At, 0, 1); PG8_STAGE(PG8_SA(0, 0), a2, voffA);
            PG8_BAR; PG8_WAIT_L(0); PG8_MMA(1, 0, At, B0); PG8_BAR; PG8_SCHED;
            PG8_STAGE(PG8_SB(0, 1), b2 + hstep, voffB);
            PG8_WAIT_V(6); PG8_BAR; PG8_MMA(1, 1, At, B1); PG8_BAR;
            PG8_LDB(B0, 1, 0); PG8_SCHED; PG8_LDA(At, 1, 0); PG8_STAGE(PG8_SA(0, 1), a2 + hstep, voffA);
            PG8_WAIT_L(8); PG8_BAR; PG8_WAIT_L(0); PG8_MMA(0, 0, At, B0); PG8_BAR; PG8_SCHED;
            PG8_LDB(B1, 1, 1); PG8_STAGE(PG8_SB(1, 0), b3, voffB);
            PG8_BAR; PG8_WAIT_L(0); PG8_MMA(0, 1, At, B1); PG8_BAR;
            PG8_LDA(At, 1, 1); PG8_STAGE(PG8_SA(1, 0), a3, voffA);
            PG8_BAR; PG8_WAIT_L(0); PG8_MMA(1, 0, At, B0); PG8_BAR; PG8_SCHED;
            PG8_STAGE(PG8_SB(1, 1), b3 + hstep, voffB);
            PG8_WAIT_V(6); PG8_BAR; PG8_MMA(1, 1, At, B1); PG8_BAR;
            }
        }
        if constexpr (ALIGN_EPI) { if (wr == 0) PG8_BAR; }
        if constexpr (!Epi::AFTER_DRAIN) { E(acc, cur, wr, wc, fr, fq); S.done(cur); }
        if (!has_next) break;
#pragma unroll
        for (int a = 0; a < 2; ++a)
#pragma unroll
            for (int b = 0; b < 2; ++b)
#pragma unroll
                for (int m = 0; m < 4; ++m)
#pragma unroll
                    for (int n = 0; n < 2; ++n) acc[a][b][m][n] = (f32x4){0.f, 0.f, 0.f, 0.f};
        cur = nxt; cA = nA; cB = nB; ++ui;
        if constexpr (ALIGN_EPI) { if (wr == 1) PG8_BAR; }
    }
    PG8_WAIT_V(0);
    if constexpr (!ALIGN_EPI) { if (wr == 0) PG8_BAR; }
    PG8_BAR;
    if constexpr (Epi::AFTER_DRAIN) { E.fused(acc, cur, wr, wc, fr, fq, lds, wid, lane); S.done(cur); }
#undef PG8_SA
#undef PG8_SB
#undef PG8_STAGE
#undef PG8_LDA
#undef PG8_LDB
#undef PG8_MMA
#undef PG8_WAIT_V
#undef PG8_WAIT_L
#undef PG8_BAR
#undef PG8_SCHED
}
}
#define GAS __attribute__((address_space(1)))
#define LAS __attribute__((address_space(3)))
typedef unsigned short bf16;
typedef unsigned v4u __attribute__((ext_vector_type(4)));
typedef float f32x4 __attribute__((ext_vector_type(4)));
typedef short bf16x8 __attribute__((ext_vector_type(8)));
typedef GAS unsigned gu32;
typedef GAS unsigned long long gu64;
#define RLX_AGENT __ATOMIC_RELAXED, __HIP_MEMORY_SCOPE_AGENT
#define LDS_WAIT() asm volatile("s_waitcnt lgkmcnt(0)" ::: "memory")
#define VM_WAIT() asm volatile("s_waitcnt vmcnt(0)" ::: "memory")
__device__ __forceinline__ unsigned long long rt() { return __builtin_amdgcn_s_memrealtime(); }
__device__ __forceinline__ unsigned f2bf(float f) { unsigned u = __builtin_bit_cast(unsigned, f); return (u + 0x7fffu + ((u >> 16) & 1u)) >> 16; }
__device__ __forceinline__ unsigned pk2(float lo, float hi) { return f2bf(lo) | (f2bf(hi) << 16); }
#define XB_TMO      128
#define XB_XCNT(j)  (256  + 64 * (j))
#define XB_XSUB(j)  (1280 + 64 * (j))
#define XB_XGEN(j)  (2304 + 64 * (j))
#define XB_TOP      3328
#define XB_TOPGEN   3392
#define XCD_BAR_WORDS 3456
#define XB_SPIN_CAP (1u << 18)

__device__ __forceinline__ unsigned xb_ld(unsigned* p)              { return __hip_atomic_load(p, __ATOMIC_RELAXED, __HIP_MEMORY_SCOPE_AGENT); }
__device__ __forceinline__ unsigned xb_add(unsigned* p, unsigned v) { return __hip_atomic_fetch_add(p, v, __ATOMIC_RELAXED, __HIP_MEMORY_SCOPE_AGENT); }
__device__ __forceinline__ unsigned xb_xcc_id() { return (unsigned)__builtin_amdgcn_s_getreg((3 << 11) | 20) & 0xFu; }
#define XB_SPIN(cond, bar) do { unsigned _sp = 0; while (cond) { __builtin_amdgcn_s_sleep(1); \
    if ((++_sp & 255u) == 0u) { if (xb_ld(&(bar)[XB_TMO])) break; if (_sp > XB_SPIN_CAP) { atomicAdd(&(bar)[XB_TMO], 1u); break; } } } } while (0)

struct XcdBarrier {
    unsigned* bar; unsigned x;
    volatile LAS unsigned* st;
};

__device__ __forceinline__ XcdBarrier xcd_barrier_post(unsigned* bar, volatile LAS unsigned* st) {
    XcdBarrier b; b.bar = bar; b.x = xb_xcc_id(); b.st = st;
    if (threadIdx.x == 0) (void)xb_add(&bar[XB_XCNT(b.x)], 1u);
    return b;
}
__device__ __forceinline__ void xcd_barrier_complete(unsigned* bar, unsigned x, unsigned& nloc, unsigned& nx) {
    const unsigned G = gridDim.x * gridDim.y * gridDim.z;
    unsigned sum, cnt, mine, sp = 0u;
    for (;;) {
        sum = 0u; cnt = 0u; mine = 0u;
#pragma unroll
        for (unsigned j = 0; j < 16; ++j) { const unsigned c = xb_ld(&bar[XB_XCNT(j)]); sum += c; cnt += (c > 0u) ? 1u : 0u; mine = (j == x) ? c : mine; }
        if (sum == G) break;
        __builtin_amdgcn_s_sleep(1);
        if ((++sp & 255u) == 0u) { if (xb_ld(&bar[XB_TMO])) break; if (sp > XB_SPIN_CAP) { atomicAdd(&bar[XB_TMO], 1u); break; } }
    }
    nloc = mine > 0u ? mine : 1u; nx = cnt > 0u ? cnt : 1u;
}

__device__ __forceinline__ void xcd_barrier(const XcdBarrier& b) {
    asm volatile("s_waitcnt vmcnt(0)" ::: "memory");
    __syncthreads();
    if (threadIdx.x == 0) {
        unsigned* bar = b.bar;
        __builtin_amdgcn_s_waitcnt(0);
        unsigned nloc = b.st[0], nx = b.st[1];
        if (nloc == 0u) { xcd_barrier_complete(bar, b.x, nloc, nx); b.st[0] = nloc; b.st[1] = nx; }
        const unsigned old = xb_add(&bar[XB_XSUB(b.x)], 1u);
        const unsigned gen = old / nloc;
        if (old + 1u == (gen + 1u) * nloc) {
            __builtin_amdgcn_fence(__ATOMIC_RELEASE, "agent");
            asm volatile("s_waitcnt vmcnt(0)" ::: "memory");
            const unsigned og = xb_add(&bar[XB_TOP], 1u);
            const unsigned tg = og / nx;
            if (og + 1u == (tg + 1u) * nx) xb_add(&bar[XB_TOPGEN], 1u);
            else XB_SPIN(xb_ld(&bar[XB_TOPGEN]) == tg, bar);
            __builtin_amdgcn_fence(__ATOMIC_ACQUIRE, "agent");
            xb_add(&bar[XB_XGEN(b.x)], 1u);
            asm volatile("s_waitcnt vmcnt(0)" ::: "memory");
        } else {
            XB_SPIN(xb_ld(&bar[XB_XGEN(b.x)]) == gen, bar);
            __builtin_amdgcn_fence(__ATOMIC_ACQUIRE, "agent");
            asm volatile("s_waitcnt vmcnt(0)" ::: "memory");
        }
    }
    __syncthreads();
}

constexpr int NWAVES = 8, NTHR = 512;
constexpr int DM = 1024, MP = 16384, MS = 256, MALL = 16640;
constexpr int NQKV = 768, NZR = 1792, RW = 512, DFF = 4096, MEMW = 512;
constexpr float LOG2E = 1.4426950408889634f;
constexpr float NORM_EPS = 1e-6f, GN_EPS = 64e-5f;

constexpr size_t OFF_Y = 0, OFF_PK = 17039360, OFF_PV = 17104896, OFF_PMK = 17170432, OFF_PMV = 17694720, OFF_PSH = 18219008, OFF_PWKV = 18226176,
                 OFF_SK = 18357248, OFF_SV = 18488320, OFF_SSH = 18619392, OFF_SWKV = 18633728, OUT_TOTAL = 18895872;
constexpr size_t KiB = 1024, MiB = 1u << 20;
constexpr size_t WS_CTL = 0, CTL_ZERO_BYTES = 64 * KiB;
constexpr size_t WS_WIN = 1 * MiB, WS_WOUT = 6 * MiB, WS_WCQ = 8 * MiB, WS_WCO = 9 * MiB, WS_WUP = 10 * MiB, WS_WDN = 18 * MiB, WS_WMKV = 26 * MiB, WS_WLORA = 28 * MiB;
constexpr size_t PART_BYTES = 1114112;
constexpr size_t WS_PART1 = 28 * MiB + 768 * KiB, WS_PART2 = WS_PART1 + PART_BYTES, WS_PART3 = WS_PART2 + PART_BYTES;
constexpr size_t WS_XN = 32 * MiB;
constexpr size_t WS_MN = 64 * MiB + 512 * KiB;
constexpr size_t WS_MKB = 66 * MiB + 512 * KiB, WS_MVB = 69 * MiB + 512 * KiB;
constexpr size_t WS_QKV = 73 * MiB;
constexpr size_t WS_RKV = 97 * MiB + 512 * KiB;
constexpr size_t WS_ZR = 146 * MiB + 256 * KiB;
constexpr size_t WS_LW = WS_ZR, WS_G = 178 * MiB + 768 * KiB;
constexpr size_t WS_AP = 203 * MiB + 256 * KiB;
constexpr size_t WS_AH = 211 * MiB + 512 * KiB;
constexpr size_t WS_XB = 211 * MiB + 512 * KiB;
constexpr size_t WS_H = 73 * MiB;
constexpr size_t WS_GB = 195 * MiB;
constexpr size_t WS_HB = 227 * MiB;
constexpr size_t WS_SB = WS_LW;
constexpr size_t WS_BON = WS_PART3;
constexpr size_t WS_END = 244 * MiB;
static_assert(WS_PART3 + PART_BYTES <= WS_XN && WS_XN + (size_t)MALL * DM * 2 <= WS_MN && WS_MVB + 3 * MiB <= WS_QKV, "ws map 1");
static_assert(WS_QKV + (size_t)MALL * NQKV * 2 <= WS_RKV && WS_RKV + (size_t)MALL * 1536 * 2 <= WS_ZR && WS_ZR + (size_t)MALL * NZR * 2 <= WS_AP, "ws map 2");
static_assert(WS_LW + (size_t)MALL * 512 * 4 <= WS_G && WS_G + (size_t)MALL * 512 * 2 <= WS_AP && WS_AP + (size_t)MALL * 256 * 2 <= WS_AH, "ws map 3");
static_assert(WS_GB >= WS_G + (size_t)MALL * 512 * 2 && WS_GB + 32 * MiB <= WS_HB && WS_HB + 16 * MiB <= WS_END, "ws map 5");
static_assert(WS_XB + (size_t)MALL * DM * 2 <= WS_END && WS_H + (size_t)MALL * DFF * 2 <= WS_AP, "ws map 4");
constexpr size_t DO_QB = (size_t)MALL * 512, DO_AH = DO_QB + (size_t)MP * 256;
static_assert(DO_AH + (size_t)MALL * 256 <= (size_t)MALL * 1024, "d_out scratch map");
constexpr int CW_BAR = 4096;

constexpr int RING_BYTES = 131072, LDSCTL_OFF = RING_BYTES, MISC_OFF = LDSCTL_OFF + 320, LDS_BYTES = 147456;

typedef float f32x16 __attribute__((ext_vector_type(16)));
typedef short bf16x4 __attribute__((ext_vector_type(4)));
typedef unsigned u32x2 __attribute__((ext_vector_type(2)));

__device__ __forceinline__ float bf2f(unsigned short b) { return __uint_as_float((unsigned)b << 16); }
__device__ __forceinline__ float wave_sum(float v) {
#pragma unroll
    for (int o = 1; o < 64; o <<= 1) v += __shfl_xor(v, o);
    return v;
}
__device__ __forceinline__ float sigmoidf_(float x) { return 1.0f / (1.0f + __expf(-x)); }

typedef const float* CFP; typedef __attribute__((address_space(4))) const CFP* InTab;
__device__ __forceinline__ InTab launder_in(InTab p) { asm volatile("" : "+s"(p)); return p; }
#define INP(k) (launder_in(F.in)[k])
struct Frame {
    LAS unsigned char* lds; volatile LAS unsigned* MISC; gu32* ctl;
    int tid, lane, wave, vcu, G;
    InTab in; float* out; unsigned char* ws;
};

__device__ __forceinline__ void p0_transpose_item(const float* W, int K, int N, bf16* WT, int row_off, const float* gk, LAS float* scr, int item, int lane) {
    const int nblk = N / 32, kb = item / nblk, nb = item % nblk, k0 = 64 * kb, n0 = 32 * nb;
#pragma unroll 8
    for (int i = 0; i < 32; ++i) { const int kk = 2 * i + (lane >> 5); float v = W[(size_t)(k0 + kk) * N + n0 + (lane & 31)]; if (gk) v *= gk[k0 + kk]; scr[kk * 33 + (lane & 31)] = v; }
    LDS_WAIT(); asm volatile("" ::: "memory");
    const int c = lane & 7;
#pragma unroll
    for (int j = 0; j < 4; ++j) { const int n = (lane >> 3) + 8 * j; const LAS float* s = scr + (8 * c) * 33 + n;
        v4u o; o.x = pk2(s[0 * 33], s[1 * 33]); o.y = pk2(s[2 * 33], s[3 * 33]); o.z = pk2(s[4 * 33], s[5 * 33]); o.w = pk2(s[6 * 33], s[7 * 33]);
        *(GAS v4u*)(WT + (size_t)(row_off + n0 + n) * K + k0 + 8 * c) = o; }
    LDS_WAIT(); asm volatile("" ::: "memory");
}
__device__ __forceinline__ void rms_row_to_bf16(const float* xrow, const float* g, bf16* orow, int lane) {
    const GAS f32x4* xr = (const GAS f32x4*)xrow + lane; const GAS f32x4* gr = (const GAS f32x4*)g + lane;
    f32x4 v[4]; float s = 0.f;
#pragma unroll
    for (int j = 0; j < 4; ++j) { v[j] = xr[64 * j]; s += (v[j].x * v[j].x + v[j].y * v[j].y) + (v[j].z * v[j].z + v[j].w * v[j].w); }
    const float rstd = 1.0f / sqrtf(wave_sum(s) * (1.f / 1024.f) + NORM_EPS);
    GAS unsigned long long* o8 = (GAS unsigned long long*)orow + lane;
#pragma unroll
    for (int j = 0; j < 4; ++j) { const f32x4 gg = gr[64 * j];
        o8[64 * j] = (unsigned long long)pk2(v[j].x * rstd * gg.x, v[j].y * rstd * gg.y) | ((unsigned long long)pk2(v[j].z * rstd * gg.z, v[j].w * rstd * gg.w) << 32); }
}
__device__ __forceinline__ void p0_prologue(Frame& F) {
    LAS float* scr = (LAS float*)(F.lds + F.wave * 16384);
    const int gw = F.vcu * NWAVES + F.wave, NGW = F.G * NWAVES;
    unsigned char* ws = F.ws;
    constexpr int I_IN = 16 * 80, I_OUT = 16 * 32, I_CQ = 16 * 16, I_MK = 16 * 16, I_MV = 16 * 16, I_CO = 8 * 32, I_UP = 16 * 128, I_DN = 64 * 32;
    constexpr int NITEMS = I_IN + I_OUT + I_CQ + I_MK + I_MV + I_CO + I_UP + I_DN;
    for (int it = gw; it < NITEMS; it += NGW) {
        int r = it;
        if (r < I_IN) { p0_transpose_item(INP(10), 1024, 2560, (bf16*)(ws + WS_WIN), 0, nullptr, scr, r, F.lane); continue; } r -= I_IN;
        if (r < I_OUT) { p0_transpose_item(INP(24), 1024, 1024, (bf16*)(ws + WS_WOUT), 0, nullptr, scr, r, F.lane); continue; } r -= I_OUT;
        if (r < I_CQ) { p0_transpose_item(INP(27), 1024, 512, (bf16*)(ws + WS_WCQ), 0, INP(25), scr, r, F.lane); continue; } r -= I_CQ;
        if (r < I_MK) { p0_transpose_item(INP(28), 1024, 512, (bf16*)(ws + WS_WMKV), 0, nullptr, scr, r, F.lane); continue; } r -= I_MK;
        if (r < I_MV) { p0_transpose_item(INP(29), 1024, 512, (bf16*)(ws + WS_WMKV), 512, nullptr, scr, r, F.lane); continue; } r -= I_MV;
        if (r < I_CO) { p0_transpose_item(INP(30), 512, 1024, (bf16*)(ws + WS_WCO), 0, nullptr, scr, r, F.lane); continue; } r -= I_CO;
        if (r < I_UP) { p0_transpose_item(INP(32), 1024, 4096, (bf16*)(ws + WS_WUP), 0, INP(31), scr, r, F.lane); continue; } r -= I_UP;
        p0_transpose_item(INP(33), 4096, 1024, (bf16*)(ws + WS_WDN), 0, nullptr, scr, r, F.lane);
    }
    {
        bf16* WL = (bf16*)(ws + WS_WLORA); const float* w2 = INP(15); const float* a2 = INP(17); const float* g2 = INP(18);
        const int gt = F.vcu * NTHR + F.tid, NGT = F.G * NTHR;
        for (int idx = gt; idx < 1536 * 256; idx += NGT) {
            const int n = idx >> 8, k = idx & 255; float v = 0.f;
            if (n < 512) { if (k < 64) v = w2[k * 512 + n]; }
            else if (n < 1024) { if (k >= 64 && k < 128) v = a2[(k - 64) * 512 + (n - 512)]; }
            else { if (k >= 128) v = g2[(k - 128) * 512 + (n - 1024)]; }
            WL[idx] = (bf16)f2bf(v);
        }
        const f32x4* ck = (const f32x4*)INP(5); const f32x4* cv = (const f32x4*)INP(6);
        u32x2* mk = (u32x2*)((bf16*)(ws + WS_MKB) + 4 * 256 * 512); u32x2* mv = (u32x2*)((bf16*)(ws + WS_MVB) + 4 * 256 * 512);
        for (int idx = gt; idx < 8 * 256 * 512 / 4; idx += NGT) {
            const f32x4 a = ck[idx], b = cv[idx];
            mk[idx] = (u32x2){pk2(a.x, a.y), pk2(a.z, a.w)}; mv[idx] = (u32x2){pk2(b.x, b.y), pk2(b.z, b.w)};
        }
        const f32x4* ak = (const f32x4*)INP(3); const f32x4* av = (const f32x4*)INP(4);
        f32x4* ok = (f32x4*)(F.out + OFF_SK); f32x4* ov = (f32x4*)(F.out + OFF_SV);
        for (int idx = gt; idx < 8 * 96 * 32; idx += NGT) {
            const int b = idx / (96 * 32), rem = idx % (96 * 32);
            ok[b * 128 * 32 + rem] = ak[b * 128 * 32 + 32 * 32 + rem]; ov[b * 128 * 32 + rem] = av[b * 128 * 32 + 32 * 32 + rem];
        }
    }
    for (int m = gw; m < MALL + 1024; m += NGW) {
        if (m < MALL) { const float* xr = m < MP ? INP(0) + (size_t)m * DM : INP(1) + (size_t)(m - MP) * DM; rms_row_to_bf16(xr, INP(9), (bf16*)(ws + WS_XN) + (size_t)m * DM, F.lane); }
        else { const int r = m - MALL; rms_row_to_bf16(INP(2) + (size_t)r * DM, INP(26), (bf16*)(ws + WS_MN) + (size_t)r * DM, F.lane); }
    }
}

#define EPI_ROWS_BEGIN _Pragma("unroll") for (int ai = 0; ai < NAI; ++ai) _Pragma("unroll") for (int m = 0; m < 4; ++m) { const int row = row0 + ai * 128 + m * 16;
#define EPI_ROWS_END }
#define EPI_PG8_CALL __device__ __forceinline__ void operator()(const f32x4 (&acc)[2][2][4][2], const pg8::Unit& u, int wr, int wc, int fr, int fq) const { \
        this->template run<2, 128>(acc, u.pm * 256 + wr * 64 + fr, u.pn * 256 + wc * 32 + 8 * fq, u.pn * 4 + wc, fq); }
__device__ __forceinline__ v4u pack8(const f32x4 a, const f32x4 b) { v4u w; w.x = pg8::cvt_pk_bf16(a[0], a[1]); w.y = pg8::cvt_pk_bf16(a[2], a[3]); w.z = pg8::cvt_pk_bf16(b[0], b[1]); w.w = pg8::cvt_pk_bf16(b[2], b[3]); return w; }

struct EpiIn {
    static constexpr bool PERM = true, AFTER_DRAIN = false;
    bf16* QKV; bf16* ZR; float* out;
    EPI_PG8_CALL
    template <int NAI, int BJS> __device__ __forceinline__ void run(const f32x4 (&acc)[2][2][4][2], int row0, int colt, int slot, int fq) const {
        const int pn = colt >> 8;
        EPI_ROWS_BEGIN
#pragma unroll
            for (int bj = 0; bj < 2; ++bj) { const int col = colt + bj * BJS; const f32x4 v0 = acc[ai][bj][m][0], v1 = acc[ai][bj][m][1];
                const v4u w = pack8(v0, v1);
                if (pn < 3) *(v4u*)(QKV + (size_t)row * NQKV + col) = w; else *(v4u*)(ZR + (size_t)row * NZR + (col - NQKV)) = w;
                float* dst = nullptr;
                if (pn == 2) { const int cc = col - 512, kv = cc >> 7, c7 = cc & 127;
                    if (row < MP) { const int t = row & 4095; if (t >= 3968) dst = out + (kv ? OFF_PV : OFF_PK) + ((size_t)((row >> 12) * 128 + (t - 3968))) * 128 + c7; }
                    else { const int rs = row - MP; dst = out + (kv ? OFF_SV : OFF_SK) + ((size_t)((rs >> 5) * 128 + 96 + (rs & 31))) * 128 + c7; } }
                else if (pn >= 3) { const int zc = col - NQKV;
                    if (row < MP) { if ((row & 4095) == 4095) dst = out + OFF_PSH + (size_t)(row >> 12) * NZR + zc; }
                    else { const int rs = row - MP; if ((rs & 31) == 31) dst = out + OFF_SSH + (size_t)(rs >> 5) * NZR + zc; } }
                if (dst) { *(f32x4*)dst = v0; *(f32x4*)(dst + 4) = v1; } }
        EPI_ROWS_END
    }
};
struct EpiMemKV {
    static constexpr bool PERM = true, AFTER_DRAIN = false;
    bf16* MKB; bf16* MVB; float* out;
    EPI_PG8_CALL
    template <int NAI, int BJS> __device__ __forceinline__ void run(const f32x4 (&acc)[2][2][4][2], int row0, int colt, int slot, int fq) const {
        EPI_ROWS_BEGIN
#pragma unroll
            for (int bj = 0; bj < 2; ++bj) { const int col = colt + bj * BJS; const f32x4 v0 = acc[ai][bj][m][0], v1 = acc[ai][bj][m][1];
                const int kv = col >> 9, c = col & 511;
                float* dst = out + (kv ? OFF_PMV : OFF_PMK) + (size_t)row * 512 + c; *(f32x4*)dst = v0; *(f32x4*)(dst + 4) = v1;
                *(v4u*)((kv ? MVB : MKB) + (size_t)row * 512 + c) = pack8(v0, v1); }
        EPI_ROWS_END
    }
};
struct EpiLora {
    static constexpr bool PERM = true, AFTER_DRAIN = false;
    float* LW; bf16* AH; bf16* Gg; const float* w0; const float* a0;
    EPI_PG8_CALL
    template <int NAI, int BJS> __device__ __forceinline__ void run(const f32x4 (&acc)[2][2][4][2], int row0, int colt, int slot, int fq) const {
        const int sel = colt >> 9;
        const float* bias = sel == 0 ? w0 : a0; const float mul = sel == 0 ? -0.6065306597f : 1.0f;
        EPI_ROWS_BEGIN
#pragma unroll
            for (int bj = 0; bj < 2; ++bj) { const int c = (colt + bj * BJS) & 511; f32x4 v0 = acc[ai][bj][m][0], v1 = acc[ai][bj][m][1];
                if (sel < 2) {
#pragma unroll
                    for (int e = 0; e < 4; ++e) { v0[e] = mul * sigmoidf_(v0[e] + bias[c + e]); v1[e] = mul * sigmoidf_(v1[e] + bias[c + 4 + e]); } }
                if (sel == 0) { float* dst = LW + (size_t)row * 512 + c; *(f32x4*)dst = v0; *(f32x4*)(dst + 4) = v1; }
                else *(v4u*)((sel == 1 ? AH : Gg) + (size_t)row * 512 + c) = pack8(v0, v1); }
        EPI_ROWS_END
    }
};
struct EpiRes {
    static constexpr bool PERM = true, AFTER_DRAIN = false;
    const float* resP; const float* resS; float* out; bf16* XB; float* PART;
    EPI_PG8_CALL
    template <int NAI, int BJS> __device__ __forceinline__ void run(const f32x4 (&acc)[2][2][4][2], int row0, int colt, int slot, int fq) const {
        EPI_ROWS_BEGIN
            const float* rp = row < MP ? resP + (size_t)row * DM : resS + (size_t)(row - MP) * DM; float ss = 0.f;
#pragma unroll
            for (int bj = 0; bj < 2; ++bj) { const int col = colt + bj * BJS;
                const f32x4 v0 = acc[ai][bj][m][0] + *(const f32x4*)(rp + col), v1 = acc[ai][bj][m][1] + *(const f32x4*)(rp + col + 4);
                float* dst = out + (size_t)row * DM + col; *(f32x4*)dst = v0; *(f32x4*)(dst + 4) = v1;
                if (XB) *(v4u*)(XB + (size_t)row * DM + col) = pack8(v0, v1);
                ss += (v0[0] * v0[0] + v0[1] * v0[1]) + (v0[2] * v0[2] + v0[3] * v0[3]) + (v1[0] * v1[0] + v1[1] * v1[1]) + (v1[2] * v1[2] + v1[3] * v1[3]); }
            ss += __shfl_xor(ss, 16); ss += __shfl_xor(ss, 32);
            if (fq == 0) PART[(size_t)row * 16 + slot] = ss;
        EPI_ROWS_END
    }
};
template <int ACT  > struct EpiNormBf16 {
    static constexpr bool PERM = true, AFTER_DRAIN = false;
    bf16* O; int ldc; const float* PART; float scale;
    EPI_PG8_CALL
    template <int NAI, int BJS> __device__ __forceinline__ void run(const f32x4 (&acc)[2][2][4][2], int row0, int colt, int slot, int fq) const {
        EPI_ROWS_BEGIN
            const f32x4 pp = *(const f32x4*)(PART + (size_t)row * 16 + 4 * fq); float ss = (pp[0] + pp[1]) + (pp[2] + pp[3]);
            ss += __shfl_xor(ss, 16); ss += __shfl_xor(ss, 32);
            const float rs = scale / sqrtf(ss * (1.f / 1024.f) + NORM_EPS);
#pragma unroll
            for (int bj = 0; bj < 2; ++bj) { const int col = colt + bj * BJS; f32x4 v0 = acc[ai][bj][m][0] * rs, v1 = acc[ai][bj][m][1] * rs;
                if (ACT == 1) {
#pragma unroll
                    for (int e = 0; e < 4; ++e) { const float a = fmaxf(v0[e], 0.f), b = fmaxf(v1[e], 0.f); v0[e] = a * a; v1[e] = b * b; } }
                *(v4u*)(O + (size_t)row * ldc + col) = pack8(v0, v1); }
        EPI_ROWS_END
    }
};

template <class Epi> __device__ __forceinline__ void small_gemm(Frame& F, const bf16* A, const bf16* Bt, int K, int N, const Epi& E) {
    const int ntile = 4 * (N / 64), lane = F.lane, wave = F.wave, fr = lane & 15, fq = lane >> 4;
    const int bx = (int)blockIdx.x;
    LAS f32x4* red = (LAS f32x4*)F.lds;
    for (int t = F.G - 1 - bx; t < ntile; t += F.G) {
        const int rowbase = MP + 64 * (t & 3), colbase = 64 * (t >> 2);
        f32x4 acc[2][2][4][2];
#pragma unroll
        for (int bj = 0; bj < 2; ++bj)
#pragma unroll
            for (int m = 0; m < 4; ++m)
#pragma unroll
                for (int n = 0; n < 2; ++n) { acc[0][bj][m][n] = (f32x4){0.f, 0.f, 0.f, 0.f}; acc[1][bj][m][n] = (f32x4){0.f, 0.f, 0.f, 0.f}; }
        const int kslice = K >> 3, kbeg = wave * kslice;
        const bf16* ap = A + (size_t)(rowbase + fr) * K + kbeg + 8 * fq;
        const bf16* bp = Bt + (size_t)(colbase + 8 * (fr >> 2) + (fr & 3)) * K + kbeg + 8 * fq;
#pragma unroll 2
        for (int k0 = 0; k0 < kslice; k0 += 32) {
            bf16x8 af[4], wf[2][2];
#pragma unroll
            for (int m = 0; m < 4; ++m) af[m] = *(const bf16x8*)(ap + (size_t)(16 * m) * K + k0);
#pragma unroll
            for (int bj = 0; bj < 2; ++bj)
#pragma unroll
                for (int n = 0; n < 2; ++n) wf[bj][n] = *(const bf16x8*)(bp + (size_t)(32 * bj + 4 * n) * K + k0);
#pragma unroll
            for (int bj = 0; bj < 2; ++bj)
#pragma unroll
                for (int m = 0; m < 4; ++m)
#pragma unroll
                    for (int n = 0; n < 2; ++n) acc[0][bj][m][n] = __builtin_amdgcn_mfma_f32_16x16x32_bf16(wf[bj][n], af[m], acc[0][bj][m][n], 0, 0, 0);
        }
#pragma unroll
        for (int step = 4; step >= 1; step >>= 1) {
            __syncthreads();
            if (wave >= step && wave < 2 * step) {
#pragma unroll
                for (int bj = 0; bj < 2; ++bj)
#pragma unroll
                    for (int m = 0; m < 4; ++m)
#pragma unroll
                        for (int n = 0; n < 2; ++n) red[((wave - step) * 16 + (bj * 8 + m * 2 + n)) * 64 + lane] = acc[0][bj][m][n]; }
            __syncthreads();
            if (wave < step) {
#pragma unroll
                for (int bj = 0; bj < 2; ++bj)
#pragma unroll
                    for (int m = 0; m < 4; ++m)
#pragma unroll
                        for (int n = 0; n < 2; ++n) acc[0][bj][m][n] += red[(wave * 16 + (bj * 8 + m * 2 + n)) * 64 + lane]; }
        }
        if (wave == 0) E.template run<1, 32>(acc, rowbase + fr, colbase + 8 * fq, colbase >> 6, fq);
    }
    __syncthreads();
}

__device__ __forceinline__ void p2_prep(Frame& F) {
    const int gw = F.vcu * NWAVES + F.wave, NGW = F.G * NWAVES;
    const bf16* ZR = (const bf16*)(F.ws + WS_ZR); bf16* RKV = (bf16*)(F.ws + WS_RKV); bf16* AP = (bf16*)(F.ws + WS_AP);
    const float* mu = INP(13); const float* sshift = INP(7);
    for (int m = gw; m < MALL; m += NGW) {
        const int t = m < MP ? (m & 4095) : ((m - MP) & 31);
        for (int ch = F.lane; ch < NZR / 8; ch += 64) {
            const int col = ch * 8;
            const v4u cu = *(const v4u*)(ZR + (size_t)m * NZR + col);
            float cur[8], prv[8];
#pragma unroll
            for (int e = 0; e < 4; ++e) { cur[2 * e] = __uint_as_float(cu[e] << 16); cur[2 * e + 1] = __uint_as_float(cu[e] & 0xffff0000u); }
            if (t > 0) { const v4u pu = *(const v4u*)(ZR + (size_t)(m - 1) * NZR + col);
#pragma unroll
                for (int e = 0; e < 4; ++e) { prv[2 * e] = __uint_as_float(pu[e] << 16); prv[2 * e + 1] = __uint_as_float(pu[e] & 0xffff0000u); } }
            else if (m >= MP) { const float* sp = sshift + (size_t)((m - MP) >> 5) * NZR + col;
#pragma unroll
                for (int e = 0; e < 8; ++e) prv[e] = sp[e]; }
            else {
#pragma unroll
                for (int e = 0; e < 8; ++e) prv[e] = 0.f; }
            float zs[8];
#pragma unroll
            for (int e = 0; e < 8; ++e) zs[e] = cur[e] + (prv[e] - cur[e]) * mu[col + e];
            if (col >= 1536) {
                if (col < 1600) {
#pragma unroll
                    for (int e = 0; e < 8; ++e) zs[e] = tanhf(zs[e]); }
                else if (col >= 1664) {
#pragma unroll
                    for (int e = 0; e < 8; ++e) zs[e] = sigmoidf_(zs[e]); }
            }
            v4u w; w.x = pk2(zs[0], zs[1]); w.y = pk2(zs[2], zs[3]); w.z = pk2(zs[4], zs[5]); w.w = pk2(zs[6], zs[7]);
            if (col < 1536) *(v4u*)(RKV + (size_t)m * 1536 + col) = w; else *(v4u*)(AP + (size_t)m * 256 + (col - 1536)) = w;
        }
    }
}

constexpr int CK_STR = 144;
constexpr int CK_AT = 0, CK_BT = 9216, CK_KT = 18432, CK_RT = 27648, CK_VT = 36864, CK_BPT = 46080, CK_KPT = 55296, CK_MAK = 64512, CK_MRB = 73728, CK_MRK = 82944,
              CK_L = 92160  , CK_X = 108544  , CK_DC = 125952  , CK_TOT = 126208  ;
constexpr int CK_X2 = CK_BT;
constexpr int CK_SA0T = CK_MAK, CK_PT = CK_L;
static_assert(CK_TOT + 2048 <= RING_BYTES, "chunk LDS map");
__device__ __forceinline__ float allreduce16(float v) {
    v += __int_as_float(__builtin_amdgcn_update_dpp(0, __float_as_int(v), 0xB1, 0xf, 0xf, false));
    v += __int_as_float(__builtin_amdgcn_update_dpp(0, __float_as_int(v), 0x4E, 0xf, 0xf, false));
    v += __int_as_float(__builtin_amdgcn_update_dpp(0, __float_as_int(v), 0x141, 0xf, 0xf, false));
    v += __int_as_float(__builtin_amdgcn_update_dpp(0, __float_as_int(v), 0x140, 0xf, 0xf, false));
    return v;
}
__device__ __forceinline__ float wave_sum_fast(float v) {
    const int a = __float_as_int(allreduce16(v));
    return (__int_as_float(__builtin_amdgcn_readlane(a, 0)) + __int_as_float(__builtin_amdgcn_readlane(a, 16))) + (__int_as_float(__builtin_amdgcn_readlane(a, 32)) + __int_as_float(__builtin_amdgcn_readlane(a, 48)));
}
__device__ __forceinline__ void mm64(const LAS unsigned char* Am, const LAS unsigned char* Bm, f32x4 (&acc)[2], int wave, int lane) {
    const int mt = wave >> 1, fr = lane & 15, fq = lane >> 4;
#pragma unroll
    for (int ks = 0; ks < 2; ++ks) { const bf16x8 af = *(const LAS bf16x8*)(Am + (16 * mt + fr) * CK_STR + (32 * ks + 8 * fq) * 2);
#pragma unroll
        for (int q = 0; q < 2; ++q) { const bf16x8 bfr = *(const LAS bf16x8*)(Bm + (16 * (2 * (wave & 1) + q) + fr) * CK_STR + (32 * ks + 8 * fq) * 2);
            acc[q] = __builtin_amdgcn_mfma_f32_16x16x32_bf16(af, bfr, acc[q], 0, 0, 0); } }
}
#define CK_ZERO(acc) do { acc[0] = (f32x4){0.f, 0.f, 0.f, 0.f}; acc[1] = (f32x4){0.f, 0.f, 0.f, 0.f}; } while (0)
__device__ __forceinline__ void p4_chunk_job(Frame& F, int job) {
    const int bh = job >> 6, cc = job & 63, b = bh >> 3, h = bh & 7, m0 = b * 4096 + cc * 64;
    const int lane = F.lane, wave = F.wave, tid = F.tid, hc = h * 64 + lane;
    LAS unsigned char* lds = F.lds;
    const bf16* RKV = (const bf16*)(F.ws + WS_RKV); const float* LW = (const float*)(F.ws + WS_LW); const bf16* AH = (const bf16*)(F.out + DO_AH);
    float* BON = (float*)(F.ws + WS_BON); float* Yraw = F.out; bf16* QB = (bf16*)(F.out + DO_QB);
    float* GB = (float*)(F.ws + WS_GB) + (size_t)job * 4096; bf16* HB = (bf16*)(F.ws + WS_HB) + (size_t)job * 4096;
    __syncthreads();
    {
        const float kkw = INP(19)[hc], kaw = INP(20)[hc], rkw = INP(21)[hc];
        float gr[8], gk[8], gv[8], gl[8], ga[8], cum[8];
#pragma unroll
        for (int q = 0; q < 8; ++q) { const size_t mm = (size_t)(m0 + 8 * wave + q);
            gr[q] = bf2f(RKV[mm * 1536 + hc]); gk[q] = bf2f(RKV[mm * 1536 + 512 + hc]); gv[q] = bf2f(RKV[mm * 1536 + 1024 + hc]); gl[q] = LW[mm * 512 + hc]; ga[q] = bf2f(AH[mm * 512 + hc]); }
        float run = 0.f;
#pragma unroll
        for (int q = 0; q < 8; ++q) { run += gl[q]; cum[q] = run; }
        LAS float* tot = (LAS float*)(lds + CK_TOT);
        tot[wave * 64 + lane] = run;
        __syncthreads();
        float off = 0.f, cumC = 0.f;
#pragma unroll
        for (int w2 = 0; w2 < 8; ++w2) { const float tv = tot[w2 * 64 + lane]; cumC += tv; if (w2 < wave) off += tv; }
        if (wave == 0) ((LAS float*)(lds + CK_DC))[lane] = __expf(cumC);
#pragma unroll
        for (int q = 0; q < 8; ++q) { const int t = 8 * wave + q; const float cu = off + cum[q];
            float kk = gk[q] * kkw; const float n2 = wave_sum_fast(kk * kk); kk = kk / fmaxf(sqrtf(n2), 1e-12f);
            const float kp = gk[q] * (1.0f + (ga[q] - 1.0f) * kaw); const float bon = wave_sum_fast(gr[q] * kp * rkw);
            const float av = -kk, bv = kk * ga[q];
            const float e1 = __expf(cu - gl[q]), e2 = __expf(-cu), e3 = __expf(cu), e4 = __expf(cumC - cu);
            *(LAS bf16*)(lds + CK_AT + t * CK_STR + lane * 2) = (bf16)f2bf(av * e1); *(LAS bf16*)(lds + CK_BT + t * CK_STR + lane * 2) = (bf16)f2bf(bv * e2);
            *(LAS bf16*)(lds + CK_KT + t * CK_STR + lane * 2) = (bf16)f2bf(kp * e2); *(LAS bf16*)(lds + CK_RT + t * CK_STR + lane * 2) = (bf16)f2bf(gr[q] * e3);
            *(LAS bf16*)(lds + CK_VT + lane * CK_STR + t * 2) = (bf16)f2bf(gv[q]); *(LAS bf16*)(lds + CK_BPT + lane * CK_STR + t * 2) = (bf16)f2bf(bv * e4);
            *(LAS bf16*)(lds + CK_KPT + lane * CK_STR + t * 2) = (bf16)f2bf(kp * e4);
            if (lane == 0) BON[(size_t)(m0 + t) * 8 + h] = bon; }
    }
    __syncthreads();
    const int fr = lane & 15, fq = lane >> 4, mt = wave >> 1;
    f32x4 acc[2];
#define CK_STORE_TS(img, strict) do { _Pragma("unroll") for (int q = 0; q < 2; ++q) { const int n = 16 * (2 * (wave & 1) + q) + fr, mb_ = 16 * mt + 4 * fq; float o_[4]; \
        _Pragma("unroll") for (int e = 0; e < 4; ++e) o_[e] = ((strict) ? (mb_ + e < n) : (mb_ + e <= n)) ? acc[q][e] : 0.f; \
        u32x2 w_; w_.x = pg8::cvt_pk_bf16(o_[0], o_[1]); w_.y = pg8::cvt_pk_bf16(o_[2], o_[3]); *(LAS u32x2*)(lds + (img) + n * CK_STR + mb_ * 2) = w_; } } while (0)
    CK_ZERO(acc); mm64(lds + CK_KT, lds + CK_AT, acc, wave, lane); CK_STORE_TS(CK_MAK, true);
    CK_ZERO(acc); mm64(lds + CK_BT, lds + CK_RT, acc, wave, lane); CK_STORE_TS(CK_MRB, false);
    CK_ZERO(acc); mm64(lds + CK_KT, lds + CK_RT, acc, wave, lane); CK_STORE_TS(CK_MRK, false);
    CK_ZERO(acc); mm64(lds + CK_BT, lds + CK_AT, acc, wave, lane);
#pragma unroll
    for (int q = 0; q < 2; ++q) { const int n = 16 * (2 * (wave & 1) + q) + fr, mb_ = 16 * mt + 4 * fq; f32x4 o;
#pragma unroll
        for (int e = 0; e < 4; ++e) o[e] = (mb_ + e < n) ? acc[q][e] : 0.f;
        *(LAS f32x4*)(lds + CK_L + (n * 64 + mb_) * 4) = o; }
    __syncthreads();
    CK_ZERO(acc); mm64(lds + CK_MAK, lds + CK_VT, acc, wave, lane);
#pragma unroll
    for (int q = 0; q < 2; ++q) { const int n = 16 * (2 * (wave & 1) + q) + fr, mb_ = 16 * mt + 4 * fq; *(LAS f32x4*)(lds + CK_X + (n * 68 + mb_) * 4) = acc[q]; }
    __syncthreads();
    for (int idx = tid; idx < 4096; idx += NTHR) { const int j = idx & 63, t = idx >> 6; *(LAS float*)(lds + CK_X2 + (j * 68 + t) * 4) = bf2f(*(const LAS bf16*)(lds + CK_AT + t * CK_STR + j * 2)); }
    __syncthreads();
    {
        const LAS float* Lp = (const LAS float*)(lds + CK_L);
        LAS float* Tinv = (LAS float*)(lds + CK_MAK);
        const int cl = lane & 15;
        if (wave < 4) {
            int zoff = 0; asm volatile("" : "+v"(zoff));
            const LAS float* Lb = Lp + (16 * wave) * 64 + 16 * wave + zoff;
            f32x4 lr[15][4];
#pragma unroll
            for (int tt = 1; tt < 16; ++tt)
#pragma unroll
                for (int s4 = 0; s4 < (tt + 3) / 4; ++s4) lr[tt - 1][s4] = *(const LAS f32x4*)(Lb + tt * 64 + 4 * s4);
            __builtin_amdgcn_sched_barrier(0);
            float z[16];
#pragma unroll
            for (int tt = 0; tt < 16; ++tt) z[tt] = (tt == cl) ? 1.f : 0.f;
#pragma unroll
            for (int tt = 1; tt < 16; ++tt) { float a0 = z[tt], a1 = 0.f;
#pragma unroll
                for (int s4 = 0; s4 < (tt + 3) / 4; ++s4) { const f32x4 l4 = lr[tt - 1][s4]; a0 += l4[0] * z[4 * s4]; a1 += l4[1] * z[4 * s4 + 1]; a0 += l4[2] * z[4 * s4 + 2]; a1 += l4[3] * z[4 * s4 + 3]; }
                z[tt] = a0 + a1; }
            if (lane < 16) {
#pragma unroll
                for (int tt = 0; tt < 16; ++tt) Tinv[wave * 256 + tt * 16 + cl] = z[tt]; }
        }
        __syncthreads();
        LAS float* xcol = (LAS float*)(lds + (wave < 4 ? CK_X + (16 * wave + cl) * 272 : CK_X2 + (16 * (wave - 4) + cl) * 272));
#pragma unroll
        for (int tb = 0; tb < 4; ++tb) {
            if (tb > 0) {
                f32x4 ua = *(LAS f32x4*)(xcol + 16 * tb + 4 * fq);
#pragma unroll
                for (int ks = 0; ks < 4 * tb; ++ks) ua = __builtin_amdgcn_mfma_f32_16x16x4f32(Lp[(16 * tb + cl) * 64 + 4 * ks + fq], xcol[4 * ks + fq], ua, 0, 0, 0);
                *(LAS f32x4*)(xcol + 16 * tb + 4 * fq) = ua;
            }
            f32x4 ya = (f32x4){0.f, 0.f, 0.f, 0.f};
#pragma unroll
            for (int ks = 0; ks < 4; ++ks) ya = __builtin_amdgcn_mfma_f32_16x16x4f32(Tinv[tb * 256 + cl * 16 + 4 * ks + fq], xcol[16 * tb + 4 * ks + fq], ya, 0, 0, 0);
            *(LAS f32x4*)(xcol + 16 * tb + 4 * fq) = ya;
        }
    }
    __syncthreads();
    for (int idx = tid; idx < 2 * 64 * 8; idx += NTHR) {
        const int which = idx >> 9, row = (idx >> 3) & 63, c8 = idx & 7; const LAS float* src = (const LAS float*)(lds + (which ? CK_X2 : CK_X) + row * 272 + c8 * 32);
        const f32x4 v0 = *(const LAS f32x4*)src, v1 = *(const LAS f32x4*)(src + 4);
        *(LAS v4u*)(lds + (which ? CK_PT : CK_SA0T) + row * CK_STR + c8 * 16) = pack8(v0, v1); }
    __syncthreads();
    {
        CK_ZERO(acc); mm64(lds + CK_PT, lds + CK_MRB, acc, wave, lane);
#pragma unroll
        for (int q = 0; q < 2; ++q) { const int n = 16 * (2 * (wave & 1) + q) + fr, mb_ = 16 * mt + 4 * fq;
            const u32x2 rr = *(const LAS u32x2*)(lds + CK_RT + n * CK_STR + mb_ * 2);
            const float o0 = acc[q][0] + __uint_as_float(rr.x << 16), o1 = acc[q][1] + __uint_as_float(rr.x & 0xffff0000u), o2 = acc[q][2] + __uint_as_float(rr.y << 16), o3 = acc[q][3] + __uint_as_float(rr.y & 0xffff0000u);
            u32x2 w; w.x = pg8::cvt_pk_bf16(o0, o1); w.y = pg8::cvt_pk_bf16(o2, o3); *(u32x2*)(QB + (size_t)(m0 + n) * 512 + h * 64 + mb_) = w; }
    }
    {
        CK_ZERO(acc); mm64(lds + CK_SA0T, lds + CK_MRB, acc, wave, lane); mm64(lds + CK_VT, lds + CK_MRK, acc, wave, lane);
#pragma unroll
        for (int q = 0; q < 2; ++q) { const int n = 16 * (2 * (wave & 1) + q) + fr, mb_ = 16 * mt + 4 * fq; *(f32x4*)(Yraw + (size_t)(m0 + n) * 512 + h * 64 + mb_) = acc[q]; }
    }
    {
        CK_ZERO(acc); mm64(lds + CK_BPT, lds + CK_PT, acc, wave, lane);
        const LAS float* dcp = (const LAS float*)(lds + CK_DC);
#pragma unroll
        for (int q = 0; q < 2; ++q) { const int n = 16 * (2 * (wave & 1) + q) + fr, mb_ = 16 * mt + 4 * fq; f32x4 o = acc[q]; const float dn = dcp[n];
#pragma unroll
            for (int e = 0; e < 4; ++e) if (mb_ + e == n) o[e] += dn;
            *(f32x4*)(GB + n * 64 + mb_) = o; }
    }
    {
        CK_ZERO(acc); mm64(lds + CK_BPT, lds + CK_SA0T, acc, wave, lane); mm64(lds + CK_KPT, lds + CK_VT, acc, wave, lane);
#pragma unroll
        for (int q = 0; q < 2; ++q) { const int n = 16 * (2 * (wave & 1) + q) + fr, mb_ = 16 * mt + 4 * fq;
            u32x2 w; w.x = pg8::cvt_pk_bf16(acc[q][0], acc[q][1]); w.y = pg8::cvt_pk_bf16(acc[q][2], acc[q][3]); *(u32x2*)(HB + n * 64 + mb_) = w; }
    }
#undef CK_STORE_TS
}
constexpr int SC_TT = 32;
constexpr int SC_BUF_FLOATS = 6 * SC_TT * 64;
__device__ __forceinline__ void p4_sample_scan_job(Frame& F, int bh) {
    const int b = bh >> 3, h = bh & 7; const int m0 = MP + b * 32;
    const bf16* RKV = (const bf16*)(F.ws + WS_RKV); const float* LW = (const float*)(F.ws + WS_LW); const bf16* AH = (const bf16*)(F.out + DO_AH);
    float* BON = (float*)(F.ws + WS_BON); float* Yo = F.out;
    LAS float* Lb = (LAS float*)F.lds;
    const int lane = F.lane, wave = F.wave, hc = h * 64 + lane;
    const float kkw = INP(19)[hc], kaw = INP(20)[hc], rkw = INP(21)[hc];
    const int rs = lane >> 4, jq = lane & 15, i0 = 8 * wave + rs, i1 = i0 + 4;
    float S0, S1, S2, S3, U0, U1, U2, U3;
    { const float* st = INP(8) + ((size_t)(bh * 64)) * 64 + 4 * jq; const f32x4 s = *(const f32x4*)(st + (size_t)i0 * 64), u = *(const f32x4*)(st + (size_t)i1 * 64);
      S0 = s[0]; S1 = s[1]; S2 = s[2]; S3 = s[3]; U0 = u[0]; U1 = u[1]; U2 = u[2]; U3 = u[3]; }
    __syncthreads();
#pragma unroll
    for (int q = 0; q < 4; ++q) { const int s = 4 * wave + q; const size_t mm = (size_t)(m0 + s);
        const float gr = bf2f(RKV[mm * 1536 + hc]), gk = bf2f(RKV[mm * 1536 + 512 + hc]), gv = bf2f(RKV[mm * 1536 + 1024 + hc]), gl = LW[mm * 512 + hc], ga = bf2f(AH[mm * 512 + hc]);
        float kk = gk * kkw; const float n2 = wave_sum_fast(kk * kk); kk = kk / fmaxf(sqrtf(n2), 1e-12f);
        const float kp = gk * (1.0f + (ga - 1.0f) * kaw); const float bon = wave_sum_fast(gr * kp * rkw);
        Lb[s * 64 + lane] = __expf(gl); Lb[2048 + s * 64 + lane] = -kk; Lb[4096 + s * 64 + lane] = kk * ga; Lb[6144 + s * 64 + lane] = kp; Lb[8192 + s * 64 + lane] = gr; Lb[10240 + s * 64 + lane] = gv;
        if (lane == 0) BON[(size_t)(m0 + s) * 8 + h] = bon; }
    __syncthreads();
    float ykeep = 0.f, zkeep = 0.f;
#pragma unroll 4
    for (int s = 0; s < SC_TT; ++s) {
        const LAS float* q_ = Lb + s * 64 + 4 * jq;
        const f32x4 w4 = *(const LAS f32x4*)q_, a4 = *(const LAS f32x4*)(q_ + 2048), b4 = *(const LAS f32x4*)(q_ + 4096), k4 = *(const LAS f32x4*)(q_ + 6144), r4 = *(const LAS f32x4*)(q_ + 8192);
        const float v = Lb[10240 + s * 64 + i0], u = Lb[10240 + s * 64 + i1];
        const float sa = allreduce16((S0 * a4[0] + S1 * a4[1]) + (S2 * a4[2] + S3 * a4[3])), ua = allreduce16((U0 * a4[0] + U1 * a4[1]) + (U2 * a4[2] + U3 * a4[3]));
        S0 = S0 * w4[0] + (sa * b4[0] + v * k4[0]); S1 = S1 * w4[1] + (sa * b4[1] + v * k4[1]); S2 = S2 * w4[2] + (sa * b4[2] + v * k4[2]); S3 = S3 * w4[3] + (sa * b4[3] + v * k4[3]);
        U0 = U0 * w4[0] + (ua * b4[0] + u * k4[0]); U1 = U1 * w4[1] + (ua * b4[1] + u * k4[1]); U2 = U2 * w4[2] + (ua * b4[2] + u * k4[2]); U3 = U3 * w4[3] + (ua * b4[3] + u * k4[3]);
        const float y = allreduce16((S0 * r4[0] + S1 * r4[1]) + (S2 * r4[2] + S3 * r4[3])), z = allreduce16((U0 * r4[0] + U1 * r4[1]) + (U2 * r4[2] + U3 * r4[3]));
        ykeep = (jq == (s & 15)) ? y : ykeep; zkeep = (jq == (s & 15)) ? z : zkeep;
        if ((s & 15) == 15) { float* yp = Yo + (size_t)(m0 + (s & 16) + jq) * 512 + h * 64; yp[i0] = ykeep; yp[i1] = zkeep; }
    }
    float* so = F.out + OFF_SWKV + (size_t)bh * 4096;
    *(f32x4*)(so + (size_t)i0 * 64 + 4 * jq) = (f32x4){S0, S1, S2, S3}; *(f32x4*)(so + (size_t)i1 * 64 + 4 * jq) = (f32x4){U0, U1, U2, U3};
}
__device__ __forceinline__ void p5_chain_job(Frame& F, int job) {
    const int bh = job >> 2, ig = job & 3, lane = F.lane, wave = F.wave, fr = lane & 15, fq = lane >> 4;
    const float* GB = (const float*)(F.ws + WS_GB) + (size_t)bh * 64 * 4096; const bf16* HB = (const bf16*)(F.ws + WS_HB) + (size_t)bh * 64 * 4096; bf16* SB = (bf16*)(F.ws + WS_SB) + (size_t)bh * 64 * 4096;
    float* pw = F.out + OFF_PWKV + (size_t)bh * 4096;
    LAS float* Sl = (LAS float*)F.lds;
    __syncthreads();
    for (int idx = F.tid; idx < 16 * 65; idx += NTHR) Sl[idx] = 0.f;
    __syncthreads();
    const int jc = 16 * (wave & 3) + fr;
    float gn[16], hn[4];
    if (wave < 4) {
#pragma unroll
        for (int ks = 0; ks < 16; ++ks) gn[ks] = GB[(size_t)(4 * ks + fq) * 64 + jc];
#pragma unroll
        for (int e = 0; e < 4; ++e) hn[e] = bf2f(HB[(size_t)(16 * ig + 4 * fq + e) * 64 + jc]);
    }
    for (int c = 0; c < 64; ++c) {
        f32x4 acc = (f32x4){0.f, 0.f, 0.f, 0.f};
        if (wave < 4) {
            float g[16];
#pragma unroll
            for (int ks = 0; ks < 16; ++ks) g[ks] = gn[ks];
#pragma unroll
            for (int e = 0; e < 4; ++e) acc[e] = hn[e];
            if (c + 1 < 64) {
#pragma unroll
                for (int ks = 0; ks < 16; ++ks) gn[ks] = GB[(size_t)(c + 1) * 4096 + (size_t)(4 * ks + fq) * 64 + jc];
#pragma unroll
                for (int e = 0; e < 4; ++e) hn[e] = bf2f(HB[(size_t)(c + 1) * 4096 + (size_t)(16 * ig + 4 * fq + e) * 64 + jc]); }
#pragma unroll
            for (int ks = 0; ks < 16; ++ks) acc = __builtin_amdgcn_mfma_f32_16x16x4f32(Sl[fr * 65 + 4 * ks + fq], g[ks], acc, 0, 0, 0);
        }
        __syncthreads();
        if (wave < 4) {
#pragma unroll
            for (int e = 0; e < 4; ++e) { Sl[(4 * fq + e) * 65 + jc] = acc[e];
                if (c + 1 < 64) SB[(size_t)(c + 1) * 4096 + (size_t)(16 * ig + 4 * fq + e) * 64 + jc] = (bf16)f2bf(acc[e]);
                else pw[(size_t)(16 * ig + 4 * fq + e) * 64 + jc] = acc[e]; }
        }
        __syncthreads();
    }
}
__device__ __forceinline__ void p5_post_wave(Frame& F, int wj) {
    const float* Yraw = F.out; const bf16* QB = (const bf16*)(F.out + DO_QB); const float* BON = (const float*)(F.ws + WS_BON);
    const bf16* RKV = (const bf16*)(F.ws + WS_RKV); const bf16* Gg = (const bf16*)(F.ws + WS_G); bf16* MIX = (bf16*)(F.ws + WS_XN); const bf16* SB = (const bf16*)(F.ws + WS_SB);
    const bool prompt = wj < 4096; int bh, cc, g;
    if (prompt) { bh = wj >> 7; cc = (wj >> 1) & 63; g = wj & 1; } else { bh = wj - 4096; cc = 0; g = 0; }
    const int b = bh >> 3, h = bh & 7, lane = F.lane, li = lane & 31, hh = lane >> 5;
    const bool corr = prompt && cc > 0;
    const int m = (prompt ? b * 4096 + cc * 64 + 32 * g : MP + b * 32) + li;
    f32x16 y[2];
#pragma unroll
    for (int mb = 0; mb < 2; ++mb)
#pragma unroll
        for (int rq = 0; rq < 4; ++rq) { const f32x4 v = *(const f32x4*)(Yraw + (size_t)m * 512 + h * 64 + 32 * mb + 8 * rq + 4 * hh);
            y[mb][4 * rq] = v[0]; y[mb][4 * rq + 1] = v[1]; y[mb][4 * rq + 2] = v[2]; y[mb][4 * rq + 3] = v[3]; }
    if (corr) {
        const bf16* sp = SB + ((size_t)(bh * 64 + cc)) * 4096;
#pragma unroll
        for (int ks = 0; ks < 4; ++ks) { const bf16x8 qf = *(const bf16x8*)(QB + (size_t)m * 512 + h * 64 + 16 * ks + 8 * hh);
#pragma unroll
            for (int mb = 0; mb < 2; ++mb) { const bf16x8 sf = *(const bf16x8*)(sp + (size_t)(32 * mb + li) * 64 + 16 * ks + 8 * hh);
                y[mb] = __builtin_amdgcn_mfma_f32_32x32x16_bf16(sf, qf, y[mb], 0, 0, 0); } }
    }
    float s1 = 0.f;
#pragma unroll
    for (int mb = 0; mb < 2; ++mb)
#pragma unroll
        for (int r = 0; r < 16; ++r) s1 += y[mb][r];
    s1 += __shfl_xor(s1, 32); const float mean = s1 * (1.f / 64.f);
    float s2 = 0.f;
#pragma unroll
    for (int mb = 0; mb < 2; ++mb)
#pragma unroll
        for (int r = 0; r < 16; ++r) { const float d = y[mb][r] - mean; s2 += d * d; }
    s2 += __shfl_xor(s2, 32); const float rstd = 1.0f / sqrtf(s2 * (1.f / 64.f) + GN_EPS);
    const float bon = BON[(size_t)m * 8 + h];
    const float* lnw = INP(22) + h * 64; const float* lnb = INP(23) + h * 64;
#pragma unroll
    for (int mb = 0; mb < 2; ++mb)
#pragma unroll
        for (int rq = 0; rq < 4; ++rq) { const int i0 = 32 * mb + 8 * rq + 4 * hh;
            const f32x4 w4 = *(const f32x4*)(lnw + i0), b4 = *(const f32x4*)(lnb + i0);
            const u32x2 vv = *(const u32x2*)(RKV + (size_t)m * 1536 + 1024 + h * 64 + i0), gg = *(const u32x2*)(Gg + (size_t)m * 512 + h * 64 + i0);
            float o[4];
#pragma unroll
            for (int e = 0; e < 4; ++e) { const unsigned vw = e < 2 ? vv.x : vv.y, gw = e < 2 ? gg.x : gg.y;
                const float vf = (e & 1) ? __uint_as_float(vw & 0xffff0000u) : __uint_as_float(vw << 16), gf = (e & 1) ? __uint_as_float(gw & 0xffff0000u) : __uint_as_float(gw << 16);
                o[e] = ((y[mb][4 * rq + e] - mean) * rstd * w4[e] + b4[e] + bon * vf) * gf; }
            u32x2 ow; ow.x = pg8::cvt_pk_bf16(o[0], o[1]); ow.y = pg8::cvt_pk_bf16(o[2], o[3]);
            *(u32x2*)(MIX + (size_t)m * DM + 512 + h * 64 + i0) = ow; }
}
template <int D, int G, int KSTR, int VSTR, class ScoreFn>
__device__ __forceinline__ void attn_group(const LAS unsigned char* Kl, const LAS unsigned char* Vl, const bf16x8 (&qf)[D / 16], f32x16 (&o)[D / 32], float& mrun, float& lrun, int lane, const ScoreFn& sf) {
    const int kr = lane & 31, hh = lane >> 5;
    f32x16 s[G];
#pragma unroll
    for (int kb = 0; kb < G; ++kb) {
#pragma unroll
        for (int e = 0; e < 16; ++e) s[kb][e] = 0.f;
#pragma unroll
        for (int ks = 0; ks < D / 16; ++ks) { const bf16x8 kf = *(const LAS bf16x8*)(Kl + (kb * 32 + kr) * KSTR + (ks * 16 + hh * 8) * 2);
            s[kb] = __builtin_amdgcn_mfma_f32_32x32x16_bf16(kf, qf[ks], s[kb], 0, 0, 0); }
    }
    float gmax = -INFINITY;
#pragma unroll
    for (int kb = 0; kb < G; ++kb)
#pragma unroll
        for (int e = 0; e < 16; ++e) { const float v = sf(kb, e, s[kb][e]); s[kb][e] = v; gmax = fmaxf(gmax, v); }
    gmax = fmaxf(gmax, __shfl_xor(gmax, 32));
    const float mn = fmaxf(mrun, gmax); const float alpha = __builtin_amdgcn_exp2f(mrun - mn); mrun = mn;
    float ps = 0.f;
#pragma unroll
    for (int kb = 0; kb < G; ++kb)
#pragma unroll
        for (int e = 0; e < 16; ++e) { const float p = __builtin_amdgcn_exp2f(s[kb][e] - mn); s[kb][e] = p; ps += p; }
    ps += __shfl_xor(ps, 32);
    lrun = lrun * alpha + ps;
#pragma unroll
    for (int db = 0; db < D / 32; ++db)
#pragma unroll
        for (int e = 0; e < 16; ++e) o[db][e] *= alpha;
    const int q4 = (lane & 15) >> 2, p4 = lane & 3, g16 = (lane >> 4) & 1;
#pragma unroll
    for (int kb = 0; kb < G; ++kb)
#pragma unroll
        for (int s2 = 0; s2 < 2; ++s2) {
            v4u pw; pw.x = pg8::cvt_pk_bf16(s[kb][8 * s2 + 0], s[kb][8 * s2 + 1]); pw.y = pg8::cvt_pk_bf16(s[kb][8 * s2 + 2], s[kb][8 * s2 + 3]);
            pw.z = pg8::cvt_pk_bf16(s[kb][8 * s2 + 4], s[kb][8 * s2 + 5]); pw.w = pg8::cvt_pk_bf16(s[kb][8 * s2 + 6], s[kb][8 * s2 + 7]);
            const bf16x8 pf = __builtin_bit_cast(bf16x8, pw);
            const int key0 = kb * 32 + 16 * s2 + 4 * hh;
#pragma unroll
            for (int db = 0; db < D / 32; ++db) {
                const LAS unsigned char* va = Vl + (key0 + q4) * VSTR + (32 * db + 16 * g16 + 4 * p4) * 2;
                const bf16x4 v0 = __builtin_amdgcn_ds_read_tr16_b64_v4i16((LAS bf16x4*)va);
                const bf16x4 v1 = __builtin_amdgcn_ds_read_tr16_b64_v4i16((LAS bf16x4*)(va + 8 * VSTR));
                const bf16x8 vf = __builtin_shufflevector(v0, v1, 0, 1, 2, 3, 4, 5, 6, 7);
                o[db] = __builtin_amdgcn_mfma_f32_32x32x16_bf16(vf, pf, o[db], 0, 0, 0);
            }
        }
}
template <int D> __device__ __forceinline__ void attn_store(const f32x16 (&o)[D / 32], float inv, bf16* orow, int lane) {
    const int hh = lane >> 5;
#pragma unroll
    for (int db = 0; db < D / 32; ++db)
#pragma unroll
        for (int rq = 0; rq < 4; ++rq) {
            u32x2 w; w.x = pg8::cvt_pk_bf16(o[db][4 * rq] * inv, o[db][4 * rq + 1] * inv); w.y = pg8::cvt_pk_bf16(o[db][4 * rq + 2] * inv, o[db][4 * rq + 3] * inv);
            *(u32x2*)(orow + 32 * db + 8 * rq + 4 * hh) = w;
        }
}

constexpr int SWA_KSTR = 144, SWA_VSTR = 192;
constexpr int SWA_K_OFF = 0, SWA_V_OFF = 192 * SWA_KSTR  , SWA_LUT_OFF = SWA_V_OFF + 192 * SWA_VSTR  ;
__device__ __forceinline__ int t5_bucket(int rel) {
    const int n = rel < 0 ? -rel : rel;
    int v = n < 8 ? n : (n < 12 ? 8 : (n < 16 ? 9 : (n < 23 ? 10 : (n < 32 ? 11 : (n < 46 ? 12 : (n < 64 ? 13 : (n < 91 ? 14 : 15)))))));
    return (rel > 0 ? 16 : 0) + v;
}
struct SwaScore { const LAS float* lut; int qi; int hh; int jlo, jhi; float sc2;
    __device__ __forceinline__ float operator()(int kb, int e, float raw) const {
        const int j = kb * 32 + (e & 3) + 8 * (e >> 2) + 4 * hh;
        const float v = raw * sc2 + lut[j - qi + 63];
        return (j >= jlo && j < jhi) ? v : -INFINITY; } };
__device__ __forceinline__ void swa_build_lut(Frame& F) {
    LAS float* lut = (LAS float*)(F.lds + SWA_LUT_OFF); const float* table = INP(12);
    for (int idx = F.tid; idx < 8 * 256; idx += NTHR) { const int h = idx >> 8, x = idx & 255; const int rel = x - 191;
        lut[idx] = x < 255 ? table[t5_bucket(rel) * 8 + h] * LOG2E : 0.f; }
}
__device__ __forceinline__ void swa_unit(Frame& F, int u) {
    const bool prompt = u < 512; int b, c, kvh;
    if (prompt) { b = u >> 7; c = (u >> 1) & 63; kvh = u & 1; } else { b = (u - 512) >> 1; c = 0; kvh = u & 1; }
    const bf16* QKV = (const bf16*)(F.ws + WS_QKV); bf16* MIX = (bf16*)(F.ws + WS_XN);
    LAS unsigned char* Kl = F.lds + SWA_K_OFF; LAS unsigned char* Vl = F.lds + SWA_V_OFF;
    __syncthreads();
    for (int idx = F.tid; idx < 192 * 8; idx += NTHR) {
        const int j = idx >> 3, c8 = idx & 7; v4u kw = (v4u){0u, 0u, 0u, 0u}, vw = (v4u){0u, 0u, 0u, 0u};
        if (prompt) { const int pos = 64 * c - 128 + j;
            if (pos >= 0) { const bf16* src = QKV + (size_t)(b * 4096 + pos) * NQKV + 512 + 64 * kvh + 8 * c8; kw = *(const v4u*)src; vw = *(const v4u*)(src + 128); } }
        else if (j < 128) { const float* sk = INP(3) + ((size_t)(b * 128 + j)) * 128 + 64 * kvh + 8 * c8; const float* sv = INP(4) + ((size_t)(b * 128 + j)) * 128 + 64 * kvh + 8 * c8;
            const f32x4 k0 = *(const f32x4*)sk, k1 = *(const f32x4*)(sk + 4), v0 = *(const f32x4*)sv, v1 = *(const f32x4*)(sv + 4);
            kw = (v4u){pk2(k0[0], k0[1]), pk2(k0[2], k0[3]), pk2(k1[0], k1[1]), pk2(k1[2], k1[3])}; vw = (v4u){pk2(v0[0], v0[1]), pk2(v0[2], v0[3]), pk2(v1[0], v1[1]), pk2(v1[2], v1[3])}; }
        else if (j < 160) { const bf16* src = QKV + (size_t)(MP + b * 32 + (j - 128)) * NQKV + 512 + 64 * kvh + 8 * c8; kw = *(const v4u*)src; vw = *(const v4u*)(src + 128); }
        *(LAS v4u*)(Kl + j * SWA_KSTR + c8 * 16) = kw; *(LAS v4u*)(Vl + j * SWA_VSTR + c8 * 16) = vw;
    }
    __syncthreads();
    const int wave = F.wave, lane = F.lane;
    const bool active = prompt || wave < 4;
    if (active) {
        const int head = 4 * kvh + (prompt ? (wave >> 1) : wave), q0 = prompt ? 32 * (wave & 1) : 0;
        const int mq = (prompt ? b * 4096 + 64 * c : MP + b * 32) + q0 + (lane & 31);
        bf16x8 qf[4];
#pragma unroll
        for (int ks = 0; ks < 4; ++ks) qf[ks] = *(const bf16x8*)(QKV + (size_t)mq * NQKV + head * 64 + ks * 16 + (lane >> 5) * 8);
        f32x16 o[2];
#pragma unroll
        for (int db = 0; db < 2; ++db)
#pragma unroll
            for (int e = 0; e < 16; ++e) o[db][e] = 0.f;
        const float sink2 = INP(11)[head] * LOG2E;
        float mrun = sink2, lrun = 0.f;
        SwaScore sf; sf.lut = (const LAS float*)(F.lds + SWA_LUT_OFF) + head * 256; sf.qi = q0 + (lane & 31); sf.hh = lane >> 5; sf.sc2 = 0.125f * LOG2E;
        if (prompt) { sf.jlo = 128 - 64 * c; sf.jhi = 192; } else { sf.jlo = 0; sf.jhi = 160; }
        attn_group<64, 6, SWA_KSTR, SWA_VSTR>(Kl, Vl, qf, o, mrun, lrun, lane, sf);
        const float den = lrun + __builtin_amdgcn_exp2f(sink2 - mrun);
        attn_store<64>(o, 1.0f / den, MIX + (size_t)mq * DM + head * 64, lane);
    }
}

constexpr int CA_KSTR = 272, CA_VSTR = 320, CA_K_OFF = 0, CA_V_OFF = 128 * CA_KSTR  ;
struct PlainScore { float sc2; __device__ __forceinline__ float operator()(int, int, float raw) const { return raw * sc2; } };
__device__ __forceinline__ void ca_unit(Frame& F, int u) {
    const bool prompt = u < 256; const int hd = u & 3; int mbase, bidx;
    if (prompt) { const int tile = u >> 2; mbase = tile * 256; bidx = tile >> 4; } else { const int b = (u - 256) >> 2; mbase = MP + b * 32; bidx = 4 + b; }
    const bf16* QC = (const bf16*)(F.ws + WS_RKV); bf16* OC = (bf16*)(F.ws + WS_XN);
    const bf16* MKB = (const bf16*)(F.ws + WS_MKB) + (size_t)bidx * 256 * 512 + hd * 128; const bf16* MVB = (const bf16*)(F.ws + WS_MVB) + (size_t)bidx * 256 * 512 + hd * 128;
    LAS unsigned char* Kl = F.lds + CA_K_OFF; LAS unsigned char* Vl = F.lds + CA_V_OFF;
    const int wave = F.wave, lane = F.lane; const bool active = prompt || wave == 0;
    const int mq = mbase + (prompt ? 32 * wave : 0) + (lane & 31);
    bf16x8 qf[8]; f32x16 o[4]; float mrun = -INFINITY, lrun = 0.f;
    if (active) {
#pragma unroll
        for (int ks = 0; ks < 8; ++ks) qf[ks] = *(const bf16x8*)(QC + (size_t)mq * 512 + hd * 128 + ks * 16 + (lane >> 5) * 8);
    }
#pragma unroll
    for (int db = 0; db < 4; ++db)
#pragma unroll
        for (int e = 0; e < 16; ++e) o[db][e] = 0.f;
    PlainScore sf; sf.sc2 = 0.08838834764831845f * LOG2E;
    for (int g = 0; g < 2; ++g) {
        __syncthreads();
        for (int idx = F.tid; idx < 128 * 16; idx += NTHR) { const int j = idx >> 4, c8 = idx & 15;
            *(LAS v4u*)(Kl + j * CA_KSTR + c8 * 16) = *(const v4u*)(MKB + (size_t)(g * 128 + j) * 512 + 8 * c8);
            *(LAS v4u*)(Vl + j * CA_VSTR + c8 * 16) = *(const v4u*)(MVB + (size_t)(g * 128 + j) * 512 + 8 * c8); }
        __syncthreads();
        if (active) attn_group<128, 4, CA_KSTR, CA_VSTR>(Kl, Vl, qf, o, mrun, lrun, lane, sf);
    }
    if (active) attn_store<128>(o, 1.0f / lrun, OC + (size_t)mq * 512 + hd * 128, lane);
}

__device__ __forceinline__ void p11_final(Frame& F) {
    const int gw = F.vcu * NWAVES + F.wave, NGW = F.G * NWAVES; const float* PART = (const float*)(F.ws + WS_PART3); const float* g = INP(34);
    for (int m = gw; m < MALL; m += NGW) {
        const f32x4 p0 = *(const f32x4*)(PART + (size_t)m * 16), p1 = *(const f32x4*)(PART + (size_t)m * 16 + 4), p2 = *(const f32x4*)(PART + (size_t)m * 16 + 8), p3 = *(const f32x4*)(PART + (size_t)m * 16 + 12);
        const float ss = ((p0[0] + p0[1]) + (p0[2] + p0[3])) + ((p1[0] + p1[1]) + (p1[2] + p1[3])) + ((p2[0] + p2[1]) + (p2[2] + p2[3])) + ((p3[0] + p3[1]) + (p3[2] + p3[3]));
        const float rs = 1.0f / sqrtf(ss * (1.f / 1024.f) + NORM_EPS);
        f32x4* xr = (f32x4*)(F.out + (size_t)m * DM) + F.lane; const f32x4* gr = (const f32x4*)g + F.lane;
#pragma unroll
        for (int j = 0; j < 4; ++j) { f32x4 v = xr[64 * j]; const f32x4 gg = gr[64 * j]; v = v * rs; v[0] *= gg[0]; v[1] *= gg[1]; v[2] *= gg[2]; v[3] *= gg[3]; xr[64 * j] = v; }
    }
}

#ifndef PROBE_ATT_REP
#define PROBE_ATT_REP 1
#endif
#ifndef PROBE_SCAN_REP
#define PROBE_SCAN_REP 1
#endif
#ifndef PROBE_PHASE
#define PROBE_PHASE -1
#endif
#ifndef MK_SPLIT
#define MK_SPLIT 0
#endif
constexpr int N_PHASES = 14;
struct Args { const float* in[35]; float* out; unsigned char* ws; int ph_lo, ph_hi; };
static_assert(sizeof(Args) == 35 * 8 + 8 + 8 + 8, "Args has no padding");

__global__ void __launch_bounds__(NTHR, 2) hymba_fwd(Args args) {
    extern __shared__ __attribute__((aligned(16))) unsigned char lds_raw[];
    Frame F;
    F.lds = (LAS unsigned char*)lds_raw; F.MISC = (volatile LAS unsigned*)(F.lds + MISC_OFF);
    F.tid = threadIdx.x; F.lane = F.tid & 63; F.wave = __builtin_amdgcn_readfirstlane(F.tid >> 6);
    F.G = gridDim.x; { const int bx = blockIdx.x; F.vcu = (F.G % 8 == 0) ? (bx % 8) * (F.G / 8) + bx / 8 : bx; }
    F.in = (InTab)__builtin_amdgcn_kernarg_segment_ptr();
    F.out = args.out; F.ws = args.ws; F.ctl = (gu32*)(args.ws + WS_CTL);
    unsigned char* ws = args.ws;
    for (int u = F.tid; u < (LDS_BYTES - LDSCTL_OFF) / 4; u += NTHR) ((LAS unsigned*)(F.lds + LDSCTL_OFF))[u] = 0u;
    __syncthreads();
    XcdBarrier bar; bar.bar = (unsigned*)(F.ctl + CW_BAR); bar.x = 0; bar.st = nullptr;
    const int lo = args.ph_lo, hi = args.ph_hi;
    if (hi - lo > 1) bar = xcd_barrier_post((unsigned*)(F.ctl + CW_BAR), F.MISC + 8);
#define IN(k) (lo <= (k) && (k) < hi)
#define FRESH() do { int t_ = threadIdx.x; asm volatile("" : "+v"(t_)); F.tid = t_; F.lane = t_ & 63; F.wave = __builtin_amdgcn_readfirstlane(t_ >> 6); } while (0)
#define SEAM(k) do { if (IN(k) && IN((k) + 1)) xcd_barrier(bar); } while (0)
    const int bx = (int)blockIdx.x;

    if (IN(0)) { FRESH(); p0_prologue(F); } SEAM(0);
    if (IN(1)) { FRESH();
        { pg8::Gemm g{(const pg8::bf16_t*)(ws + WS_XN), (const pg8::bf16_t*)(ws + WS_WIN), MALL, 2560, 1024}; pg8::StaticOrder S; S.init(MP, 2560, F.G, bx);
          EpiIn E{(bf16*)(ws + WS_QKV), (bf16*)(ws + WS_ZR), F.out};
          pg8::gemm_phase<EpiIn, pg8::StaticOrder, true, true>(F.lds, g, S, E);
          FRESH(); small_gemm(F, g.A, g.Bt, 1024, 2560, E); }
        { pg8::Gemm g{(const pg8::bf16_t*)(ws + WS_MN), (const pg8::bf16_t*)(ws + WS_WMKV), 1024, 1024, 1024}; pg8::StaticOrder S; S.init(1024, 1024, F.G, (bx + 96) % F.G);
          EpiMemKV E{(bf16*)(ws + WS_MKB), (bf16*)(ws + WS_MVB), F.out};
          pg8::gemm_phase<EpiMemKV, pg8::StaticOrder, true, true>(F.lds, g, S, E); }
    } SEAM(1);
    if (IN(2)) { FRESH(); p2_prep(F); } SEAM(2);
    if (IN(3)) { FRESH();
        pg8::Gemm g{(const pg8::bf16_t*)(ws + WS_AP), (const pg8::bf16_t*)(ws + WS_WLORA), MALL, 1536, 256}; pg8::StaticOrder S; S.init(MP, 1536, F.G, bx);
        EpiLora E{(float*)(ws + WS_LW), (bf16*)(F.out + DO_AH), (bf16*)(ws + WS_G), INP(14), INP(16)};
        pg8::gemm_phase<EpiLora, pg8::StaticOrder, true, true>(F.lds, g, S, E);
        FRESH(); small_gemm(F, g.A, g.Bt, 256, 1536, E);
    } SEAM(3);
    if (IN(4)) { FRESH();
        for (int j = F.vcu; j < 2048; j += F.G) p4_chunk_job(F, j);
        for (int j = F.vcu; j < 64; j += F.G) p4_sample_scan_job(F, j);
        { __syncthreads(); swa_build_lut(F);
          const int a0 = (F.vcu + F.G - (64 % F.G)) % F.G;
          for (int u = a0; u < 528; u += F.G) swa_unit(F, u); }
    } SEAM(4);
    if (IN(5)) { FRESH(); for (int j = F.vcu; j < 128; j += F.G) p5_chain_job(F, j); } SEAM(5);
    if (IN(6)) { FRESH(); for (int wj = F.vcu * NWAVES + F.wave; wj < 4096 + 64; wj += F.G * NWAVES) p5_post_wave(F, wj); } SEAM(6);
    if (IN(7)) { FRESH();
        pg8::Gemm g{(const pg8::bf16_t*)(ws + WS_XN), (const pg8::bf16_t*)(ws + WS_WOUT), MALL, 1024, 1024}; pg8::StaticOrder S; S.init(MP, 1024, F.G, bx);
        EpiRes E{INP(0), INP(1), F.out, (bf16*)(ws + WS_XB), (float*)(ws + WS_PART1)};
        pg8::gemm_phase<EpiRes, pg8::StaticOrder, true, true>(F.lds, g, S, E);
        FRESH(); small_gemm(F, g.A, g.Bt, 1024, 1024, E);
    } SEAM(7);
    if (IN(8)) { FRESH();
        pg8::Gemm g{(const pg8::bf16_t*)(ws + WS_XB), (const pg8::bf16_t*)(ws + WS_WCQ), MALL, 512, 1024}; pg8::StaticOrder S; S.init(MP, 512, F.G, bx);
        EpiNormBf16<0> E{(bf16*)(ws + WS_RKV), 512, (const float*)(ws + WS_PART1), 1.0f};
        pg8::gemm_phase<EpiNormBf16<0>, pg8::StaticOrder, true, true>(F.lds, g, S, E);
        FRESH(); small_gemm(F, g.A, g.Bt, 1024, 512, E);
    } SEAM(8);
    if (IN(9)) { FRESH(); for (int u = F.vcu; u < 288; u += F.G) ca_unit(F, u); } SEAM(9);
    if (IN(10)) { FRESH();
        pg8::Gemm g{(const pg8::bf16_t*)(ws + WS_XN), (const pg8::bf16_t*)(ws + WS_WCO), MALL, 1024, 512}; pg8::StaticOrder S; S.init(MP, 1024, F.G, bx);
        EpiRes E{F.out, F.out + (size_t)MP * DM, F.out, (bf16*)(ws + WS_XB), (float*)(ws + WS_PART2)};
        pg8::gemm_phase<EpiRes, pg8::StaticOrder, true, true>(F.lds, g, S, E);
        FRESH(); small_gemm(F, g.A, g.Bt, 512, 1024, E);
    } SEAM(10);
    if (IN(11)) { FRESH();
        pg8::Gemm g{(const pg8::bf16_t*)(ws + WS_XB), (const pg8::bf16_t*)(ws + WS_WUP), MALL, 4096, 1024}; pg8::StaticOrder S; S.init(MP, 4096, F.G, bx);
        EpiNormBf16<1> E{(bf16*)(ws + WS_H), 4096, (const float*)(ws + WS_PART2), 1.0f};
        pg8::gemm_phase<EpiNormBf16<1>, pg8::StaticOrder, true, true>(F.lds, g, S, E);
        FRESH(); small_gemm(F, g.A, g.Bt, 1024, 4096, E);
    } SEAM(11);
    if (IN(12)) { FRESH();
        pg8::Gemm g{(const pg8::bf16_t*)(ws + WS_H), (const pg8::bf16_t*)(ws + WS_WDN), MALL, 1024, 4096}; pg8::StaticOrder S; S.init(MP, 1024, F.G, bx);
        EpiRes E{F.out, F.out + (size_t)MP * DM, F.out, nullptr, (float*)(ws + WS_PART3)};
        pg8::gemm_phase<EpiRes, pg8::StaticOrder, true, true>(F.lds, g, S, E);
        FRESH(); small_gemm(F, g.A, g.Bt, 4096, 1024, E);
    } SEAM(12);
    if (IN(13)) { FRESH(); p11_final(F); }
#undef IN
#undef SEAM
}

extern "C" void kernel_launch(void* const* d_in, const int* in_sizes, int n_in, void* d_out, int out_size, void* d_ws, size_t ws_size, hipStream_t stream) {
    static int grid = 0;
    if (grid == 0) {
        if (n_in != 35 || out_size != (int)OUT_TOTAL || ws_size < WS_END) { fprintf(stderr, "kernel_launch: unexpected shapes: n_in %d out %d ws %zu\n", n_in, out_size, ws_size); grid = -1; return; }
        int dev = 0, cus = 0, per_cu = 0;
        if (hipGetDevice(&dev) != hipSuccess || hipDeviceGetAttribute(&cus, hipDeviceAttributeMultiprocessorCount, dev) != hipSuccess) { grid = -1; return; }
        if (hipFuncSetAttribute((const void*)hymba_fwd, hipFuncAttributeMaxDynamicSharedMemorySize, LDS_BYTES) != hipSuccess) { fprintf(stderr, "kernel_launch: hipFuncSetAttribute failed\n"); grid = -1; return; }
        if (hipOccupancyMaxActiveBlocksPerMultiprocessor(&per_cu, (const void*)hymba_fwd, NTHR, LDS_BYTES) != hipSuccess || per_cu < 1)
            fprintf(stderr, "kernel_launch: occupancy query reports %d workgroups per CU\n", per_cu);
        (void)hipGetLastError();
        grid = cus;
    }
    if (grid < 0) return;
    if (hipMemsetAsync((char*)d_ws + WS_CTL, 0, CTL_ZERO_BYTES, stream) != hipSuccess) { fprintf(stderr, "kernel_launch: memset failed\n"); return; }
    Args a{};
    for (int i = 0; i < 35; ++i) a.in[i] = (const float*)d_in[i];
    a.out = (float*)d_out; a.ws = (unsigned char*)d_ws;
#if MK_SPLIT
    for (int p = 0; p < N_PHASES; ++p) { a.ph_lo = p; a.ph_hi = p + 1; hipLaunchKernelGGL(hymba_fwd, dim3(grid), dim3(NTHR), LDS_BYTES, stream, a); }
#elif PROBE_PHASE >= 0
    a.ph_lo = 0; a.ph_hi = PROBE_PHASE + 1; hipLaunchKernelGGL(hymba_fwd, dim3(grid), dim3(NTHR), LDS_BYTES, stream, a);
    (void)hipMemsetAsync((char*)d_ws + WS_CTL, 0, CTL_ZERO_BYTES, stream);
    a.ph_lo = PROBE_PHASE; a.ph_hi = N_PHASES; hipLaunchKernelGGL(hymba_fwd, dim3(grid), dim3(NTHR), LDS_BYTES, stream, a);
#else
    a.ph_lo = 0; a.ph_hi = N_PHASES; hipLaunchKernelGGL(hymba_fwd, dim3(grid), dim3(NTHR), LDS_BYTES, stream, a);
#endif
    const hipError_t le = hipPeekAtLastError();
    if (le != hipSuccess) fprintf(stderr, "kernel_launch: launch failed: %s\n", hipGetErrorName(le));
}
```

```cpp
#define MK_SPLIT 0
#define PROBE_PHASE -1
#include <hip/hip_runtime.h>
#include <cstdio>
#include <cstdint>
namespace pg8 {
#define PG8_LAS __attribute__((address_space(3)))
typedef unsigned short bf16_t;
typedef short bf16x8 __attribute__((ext_vector_type(8)));
typedef float f32x4 __attribute__((ext_vector_type(4)));
typedef unsigned u32x4 __attribute__((ext_vector_type(4)));
constexpr int BM = 256, BK = 64, HALF = 128, HTB = HALF * BK * 2  , STAGE_BYTES = 8 * HTB, NXCD = 8, WGM = 8;

__host__ __device__ __forceinline__ int lds_byte(int r, int c) { const int st = (r >> 4) * 2 + (c >> 5), rr = r & 15, cc = c & 31, ob = rr * 64 + cc * 2; return st * 1024 + (ob ^ (((ob >> 9) & 1) << 5)); }
__host__ __device__ __forceinline__ void stage_rc(int b, int& R, int& C) { const int st = b / 1024, sb = b % 1024, swz = sb ^ (((sb >> 9) & 1) << 5); R = (st >> 1) * 16 + swz / 64; C = (st & 1) * 32 + (swz % 64) / 2; }
__host__ __device__ __forceinline__ int perm32(int rho) { const int n = rho >> 4, i = rho & 15; return 8 * (i >> 2) + 4 * n + (i & 3); }

struct Unit { int pm, pn; };
struct Gemm { const bf16_t* A; const bf16_t* Bt; int M, N, K; };

struct StaticOrder {
    int nM, nN, nwg, G, c;
    __host__ __device__ void init(int M, int N, int G_, int c_) { nM = M / BM; nN = N / BM; nwg = nM * nN; G = G_; c = c_; }
    __host__ __device__ bool next(int i, Unit& u) const {
        const long L = (long)i * G + c; if (L >= nwg) return false;
        int wgid = (int)L; { const int q = nwg / NXCD, r = nwg % NXCD, xcd = wgid % NXCD, off = wgid / NXCD; wgid = (xcd < r ? xcd * (q + 1) : r * (q + 1) + (xcd - r) * q) + off; }
        const int nig = WGM * nN, gid = wgid / nig, fm = gid * WGM, gsz = (nM - fm) < WGM ? (nM - fm) : WGM;
        u.pm = fm + ((wgid % nig) % gsz); u.pn = (wgid % nig) / gsz; return true;
    }
    __device__ __forceinline__ void a_ready(const Unit&) const {}
    __device__ __forceinline__ void done(const Unit&) const {}
};

typedef float cvt_f32x2 __attribute__((ext_vector_type(2)));
typedef __bf16 cvt_bf16x2 __attribute__((ext_vector_type(2)));
__device__ __forceinline__ unsigned cvt_pk_bf16(float lo, float hi) { const cvt_f32x2 v = {lo, hi}; return __builtin_bit_cast(unsigned, __builtin_convertvector(v, cvt_bf16x2)); }
template <class Epi, class Sched, bool ALIGN_EPI = false, bool SP2 = false>
__device__ __forceinline__ void gemm_phase(PG8_LAS unsigned char* lds, const Gemm g, const Sched& S, const Epi& E) {
    const int tid = threadIdx.x, wid = __builtin_amdgcn_readfirstlane(tid >> 6), lane = tid & 63, wr = wid >> 2, wc = wid & 3, fr = lane & 15, fq = lane >> 4;
    const int K = g.K, nt = K / BK;
    unsigned voffA[2], voffB[2];
#pragma unroll
    for (int i = 0; i < 2; ++i) { int R, C; stage_rc(tid * 16 + i * 8192, R, C); const int Rb = Epi::PERM ? ((R & ~31) + perm32(R & 31)) : R;
        voffA[i] = (unsigned)(R * K + C) * 2u; voffB[i] = (unsigned)(Rb * K + C) * 2u; }
    const size_t kstep = (size_t)(BK * 2);
    const size_t hstep = (size_t)HALF * K * 2;
    const size_t tstep = 2 * hstep;
    const unsigned ldsw = (unsigned)wid * 1024u;
    const int aoff = lds_byte(wr * 64 + fr, fq * 8), boff = lds_byte(wc * 32 + fr, fq * 8);
#define PG8_SA(b, h) (((b) * 2 + (h)) * HTB)
#define PG8_SB(b, h) ((4 + (b) * 2 + (h)) * HTB)
#define PG8_STAGE(bufoff, gbase, voff) do { _Pragma("unroll") for (int _i = 0; _i < 2; ++_i) \
        __builtin_amdgcn_global_load_lds((const unsigned*)((const char*)(gbase) + (voff)[_i]), (PG8_LAS unsigned*)(lds + (bufoff) + ldsw + _i * 8192), 16, 0, 0); } while (0)
#define PG8_LDA(dst, b, h) do { _Pragma("unroll") for (int m = 0; m < 4; ++m) _Pragma("unroll") for (int k = 0; k < 2; ++k) dst[m][k] = *(const PG8_LAS bf16x8*)(lds + PG8_SA(b, h) + aoff + m * 2048 + k * 1024); } while (0)
#define PG8_LDB(dst, b, h) do { _Pragma("unroll") for (int n = 0; n < 2; ++n) _Pragma("unroll") for (int k = 0; k < 2; ++k) dst[n][k] = *(const PG8_LAS bf16x8*)(lds + PG8_SB(b, h) + boff + n * 2048 + k * 1024); } while (0)
#define PG8_MMA(ai, bj, At, Bt) do { __builtin_amdgcn_s_setprio(1); _Pragma("unroll") for (int m = 0; m < 4; ++m) _Pragma("unroll") for (int n = 0; n < 2; ++n) _Pragma("unroll") for (int k = 0; k < 2; ++k) \
        acc[ai][bj][m][n] = __builtin_amdgcn_mfma_f32_16x16x32_bf16(Bt[n][k], At[m][k], acc[ai][bj][m][n], 0, 0, 0); __builtin_amdgcn_s_setprio(0); } while (0)
#define PG8_WAIT_V(n) asm volatile("s_waitcnt vmcnt(" #n ")" ::: "memory")
#define PG8_WAIT_L(n) asm volatile("s_waitcnt lgkmcnt(" #n ")" ::: "memory")
#define PG8_BAR __builtin_amdgcn_s_barrier()
#define PG8_SCHED __builtin_amdgcn_sched_barrier(0)
    Unit cur, nxt; int ui = 0;
    if (!S.next(0, cur)) return;
    f32x4 acc[2][2][4][2];
#pragma unroll
    for (int a = 0; a < 2; ++a)
#pragma unroll
        for (int b = 0; b < 2; ++b)
#pragma unroll
            for (int m = 0; m < 4; ++m)
#pragma unroll
                for (int n = 0; n < 2; ++n) acc[a][b][m][n] = (f32x4){0.f, 0.f, 0.f, 0.f};
    bf16x8 At[4][2], B0[2][2], B1[2][2];
    const char* cA = (const char*)g.A + (size_t)cur.pm * tstep; const char* cB = (const char*)g.Bt + (size_t)cur.pn * tstep;
    S.a_ready(cur);
    if constexpr (SP2) {
        PG8_STAGE(PG8_SB(0, 0), cB, voffB); PG8_STAGE(PG8_SB(0, 1), cB + hstep, voffB); PG8_STAGE(PG8_SA(0, 0), cA, voffA); PG8_STAGE(PG8_SA(0, 1), cA + hstep, voffA);
        if (wr == 1) PG8_BAR;
        PG8_WAIT_V(2); PG8_BAR;
        PG8_STAGE(PG8_SB(1, 0), cB + kstep, voffB); PG8_STAGE(PG8_SA(1, 0), cA + kstep, voffA); PG8_STAGE(PG8_SB(1, 1), cB + hstep + kstep, voffB);
        PG8_WAIT_V(6); PG8_BAR;
    } else {
        PG8_STAGE(PG8_SB(0, 0), cB, voffB); PG8_STAGE(PG8_SA(0, 0), cA, voffA); PG8_STAGE(PG8_SB(0, 1), cB + hstep, voffB); PG8_STAGE(PG8_SA(0, 1), cA + hstep, voffA);
        if (wr == 1) PG8_BAR;
        PG8_WAIT_V(4); PG8_BAR;
        PG8_STAGE(PG8_SB(1, 0), cB + kstep, voffB); PG8_STAGE(PG8_SA(1, 0), cA + kstep, voffA); PG8_STAGE(PG8_SB(1, 1), cB + hstep + kstep, voffB);
        PG8_WAIT_V(6); PG8_BAR;
    }
    for (;;) {
        const bool has_next = S.next(ui + 1, nxt);
        const char* nA = has_next ? (const char*)g.A + (size_t)nxt.pm * tstep : cA; const char* nB = has_next ? (const char*)g.Bt + (size_t)nxt.pn * tstep : cB;
        for (int t = 0; t < nt; t += 2) {
            const bool last = (t == nt - 2);
            const char* a1 = cA + (size_t)(t + 1) * kstep;
            const char* a2 = last ? nA : cA + (size_t)(t + 2) * kstep; const char* b2 = last ? nB : cB + (size_t)(t + 2) * kstep;
            const char* a3 = a2 + kstep; const char* b3 = b2 + kstep;
            if (last && has_next) S.a_ready(nxt);
            if constexpr (SP2) {
            PG8_LDB(B0, 0, 0); PG8_LDB(B1, 0, 1); PG8_SCHED; PG8_LDA(At, 0, 0); PG8_STAGE(PG8_SA(1, 1), a1 + hstep, voffA);
            PG8_WAIT_V(8); PG8_WAIT_L(0); PG8_BAR; PG8_MMA(0, 0, At, B0); PG8_MMA(0, 1, At, B1); PG8_BAR; PG8_SCHED;
            PG8_LDA(At, 0, 1); PG8_STAGE(PG8_SB(0, 0), b2, voffB); PG8_STAGE(PG8_SB(0, 1), b2 + hstep, voffB); PG8_STAGE(PG8_SA(0, 0), a2, voffA);
            PG8_WAIT_V(8); PG8_WAIT_L(0); PG8_BAR; PG8_MMA(1, 0, At, B0); PG8_MMA(1, 1, At, B1); PG8_BAR; PG8_SCHED;
            PG8_LDB(B0, 1, 0); PG8_LDB(B1, 1, 1); PG8_SCHED; PG8_LDA(At, 1, 0); PG8_STAGE(PG8_SA(0, 1), a2 + hstep, voffA);
            PG8_WAIT_V(8); PG8_WAIT_L(0); PG8_BAR; PG8_MMA(0, 0, At, B0); PG8_MMA(0, 1, At, B1); PG8_BAR; PG8_SCHED;
            PG8_LDA(At, 1, 1); PG8_STAGE(PG8_SB(1, 0), b3, voffB); PG8_STAGE(PG8_SB(1, 1), b3 + hstep, voffB); PG8_STAGE(PG8_SA(1, 0), a3, voffA);
            PG8_WAIT_V(8); PG8_WAIT_L(0); PG8_BAR; PG8_MMA(1, 0, At, B0); PG8_MMA(1, 1, At, B1); PG8_BAR; PG8_SCHED;
            } else {
            PG8_LDB(B0, 0, 0); PG8_SCHED; PG8_LDA(At, 0, 0); PG8_STAGE(PG8_SA(1, 1), a1 + hstep, voffA);
            PG8_WAIT_L(8); PG8_BAR; PG8_WAIT_L(0); PG8_MMA(0, 0, At, B0); PG8_BAR; PG8_SCHED;
            PG8_LDB(B1, 0, 1); PG8_STAGE(PG8_SB(0, 0), b2, voffB);
            PG8_BAR; PG8_WAIT_L(0); PG8_MMA(0, 1, At, B1); PG8_BAR;
            PG8_LDA(At, 0, 1); PG8_STAGE(PG8_SA(0, 0), a2, voffA);
            PG8_BAR; PG8_WAIT_L(0); PG8_MMA(1, 0, At, B0); PG8_BAR; PG8_SCHED;
            PG8_STAGE(PG8_SB(0, 1), b2 + hstep, voffB);
            PG8_WAIT_V(6); PG8_BAR; PG8_MMA(1, 1, At, B1); PG8_BAR;
            PG8_LDB(B0, 1, 0); PG8_SCHED; PG8_LDA(At, 1, 0); PG8_STAGE(PG8_SA(0, 1), a2 + hstep, voffA);
            PG8_WAIT_L(8); PG8_BAR; PG8_WAIT_L(0); PG8_MMA(0, 0, At, B0); PG8_BAR; PG8_SCHED;
            PG8_LDB(B1, 1, 1); PG8_STAGE(PG8_SB(1, 0), b3, voffB);
            PG8_BAR; PG8_WAIT_L(0); PG8_MMA(0, 1, At, B1); PG8_BAR;
            PG8_LDA(At, 1, 1); PG8_STAGE(PG8_SA(1, 0), a3, voffA);
            PG8_BAR; PG8_WAIT_L(0); PG8_MMA(1, 0, At, B0); PG8_BAR; PG8_SCHED;
            PG8_STAGE(PG8_SB(1, 1), b3 + hstep, voffB);
            PG8_WAIT_V(6); PG8_BAR; PG8_MMA(1, 1, At, B1); PG8_BAR;
            }
        }
        if constexpr (ALIGN_EPI) { if (wr == 0) PG8_BAR; }
        if constexpr (!Epi::AFTER_DRAIN) { E(acc, cur, wr, wc, fr, fq); S.done(cur); }
        if (!has_next) break;
#pragma unroll
        for (int a = 0; a < 2; ++a)
#pragma unroll
            for (int b = 0; b < 2; ++b)
#pragma unroll
                for (int m = 0; m < 4; ++m)
#pragma unroll
                    for (int n = 0; n < 2; ++n) acc[a][b][m][n] = (f32x4){0.f, 0.f, 0.f, 0.f};
        cur = nxt; cA = nA; cB = nB; ++ui;
        if constexpr (ALIGN_EPI) { if (wr == 1) PG8_BAR; }
    }
    PG8_WAIT_V(0);
    if constexpr (!ALIGN_EPI) { if (wr == 0) PG8_BAR; }
    PG8_BAR;
    if constexpr (Epi::AFTER_DRAIN) { E.fused(acc, cur, wr, wc, fr, fq, lds, wid, lane); S.done(cur); }
#undef PG8_SA
#undef PG8_SB
#undef PG8_STAGE
#undef PG8_LDA
#undef PG8_LDB
#undef PG8_MMA
#undef PG8_WAIT_V
#undef PG8_WAIT_L
#undef PG8_BAR
#undef PG8_SCHED
}
}
#define GAS __attribute__((address_space(1)))
#define LAS __attribute__((address_space(3)))
typedef unsigned short bf16;
typedef unsigned v4u __attribute__((ext_vector_type(4)));
typedef float f32x4 __attribute__((ext_vector_type(4)));
typedef short bf16x8 __attribute__((ext_vector_type(8)));
typedef GAS unsigned gu32;
typedef GAS unsigned long long gu64;
#define RLX_AGENT __ATOMIC_RELAXED, __HIP_MEMORY_SCOPE_AGENT
#define LDS_WAIT() asm volatile("s_waitcnt lgkmcnt(0)" ::: "memory")
#define VM_WAIT() asm volatile("s_waitcnt vmcnt(0)" ::: "memory")
__device__ __forceinline__ unsigned long long rt() { return __builtin_amdgcn_s_memrealtime(); }
__device__ __forceinline__ unsigned f2bf(float f) { unsigned u = __builtin_bit_cast(unsigned, f); return (u + 0x7fffu + ((u >> 16) & 1u)) >> 16; }
__device__ __forceinline__ unsigned pk2(float lo, float hi) { return f2bf(lo) | (f2bf(hi) << 16); }
#define XB_TMO      128
#define XB_XCNT(j)  (256  + 64 * (j))
#define XB_XSUB(j)  (1280 + 64 * (j))
#define XB_XGEN(j)  (2304 + 64 * (j))
#define XB_TOP      3328
#define XB_TOPGEN   3392
#define XCD_BAR_WORDS 3456
#define XB_SPIN_CAP (1u << 18)

__device__ __forceinline__ unsigned xb_ld(unsigned* p)              { return __hip_atomic_load(p, __ATOMIC_RELAXED, __HIP_MEMORY_SCOPE_AGENT); }
__device__ __forceinline__ unsigned xb_add(unsigned* p, unsigned v) { return __hip_atomic_fetch_add(p, v, __ATOMIC_RELAXED, __HIP_MEMORY_SCOPE_AGENT); }
__device__ __forceinline__ unsigned xb_xcc_id() { return (unsigned)__builtin_amdgcn_s_getreg((3 << 11) | 20) & 0xFu; }
#define XB_SPIN(cond, bar) do { unsigned _sp = 0; while (cond) { __builtin_amdgcn_s_sleep(1); \
    if ((++_sp & 255u) == 0u) { if (xb_ld(&(bar)[XB_TMO])) break; if (_sp > XB_SPIN_CAP) { atomicAdd(&(bar)[XB_TMO], 1u); break; } } } } while (0)

struct XcdBarrier {
    unsigned* bar; unsigned x;
    volatile LAS unsigned* st;
};

__device__ __forceinline__ XcdBarrier xcd_barrier_post(unsigned* bar, volatile LAS unsigned* st) {
    XcdBarrier b; b.bar = bar; b.x = xb_xcc_id(); b.st = st;
    if (threadIdx.x == 0) (void)xb_add(&bar[XB_XCNT(b.x)], 1u);
    return b;
}
__device__ __forceinline__ void xcd_barrier_complete(unsigned* bar, unsigned x, unsigned& nloc, unsigned& nx) {
    const unsigned G = gridDim.x * gridDim.y * gridDim.z;
    unsigned sum, cnt, mine, sp = 0u;
    for (;;) {
        sum = 0u; cnt = 0u; mine = 0u;
#pragma unroll
        for (unsigned j = 0; j < 16; ++j) { const unsigned c = xb_ld(&bar[XB_XCNT(j)]); sum += c; cnt += (c > 0u) ? 1u : 0u; mine = (j == x) ? c : mine; }
        if (sum == G) break;
        __builtin_amdgcn_s_sleep(1);
        if ((++sp & 255u) == 0u) { if (xb_ld(&bar[XB_TMO])) break; if (sp > XB_SPIN_CAP) { atomicAdd(&bar[XB_TMO], 1u); break; } }
    }
    nloc = mine > 0u ? mine : 1u; nx = cnt > 0u ? cnt : 1u;
}

__device__ __forceinline__ void xcd_barrier(const XcdBarrier& b) {
    asm volatile("s_waitcnt vmcnt(0)" ::: "memory");
    __syncthreads();
    if (threadIdx.x == 0) {
        unsigned* bar = b.bar;
        __builtin_amdgcn_s_waitcnt(0);
        unsigned nloc = b.st[0], nx = b.st[1];
        if (nloc == 0u) { xcd_barrier_complete(bar, b.x, nloc, nx); b.st[0] = nloc; b.st[1] = nx; }
        const unsigned old = xb_add(&bar[XB_XSUB(b.x)], 1u);
        const unsigned gen = old / nloc;
        if (old + 1u == (gen + 1u) * nloc) {
            __builtin_amdgcn_fence(__ATOMIC_RELEASE, "agent");
            asm volatile("s_waitcnt vmcnt(0)" ::: "memory");
            const unsigned og = xb_add(&bar[XB_TOP], 1u);
            const unsigned tg = og / nx;
            if (og + 1u == (tg + 1u) * nx) xb_add(&bar[XB_TOPGEN], 1u);
            else XB_SPIN(xb_ld(&bar[XB_TOPGEN]) == tg, bar);
            __builtin_amdgcn_fence(__ATOMIC_ACQUIRE, "agent");
            xb_add(&bar[XB_XGEN(b.x)], 1u);
            asm volatile("s_waitcnt vmcnt(0)" ::: "memory");
        } else {
            XB_SPIN(xb_ld(&bar[XB_XGEN(b.x)]) == gen, bar);
            __builtin_amdgcn_fence(__ATOMIC_ACQUIRE, "agent");
            asm volatile("s_waitcnt vmcnt(0)" ::: "memory");
        }
    }
    __syncthreads();
}

constexpr int NWAVES = 8, NTHR = 512;
constexpr int DM = 1024, MP = 16384, MS = 256, MALL = 16640;
constexpr int NQKV = 768, NZR = 1792, RW = 512, DFF = 4096, MEMW = 512;
constexpr float LOG2E = 1.4426950408889634f;
constexpr float NORM_EPS = 1e-6f, GN_EPS = 64e-5f;

constexpr size_t OFF_Y = 0, OFF_PK = 17039360, OFF_PV = 17104896, OFF_PMK = 17170432, OFF_PMV = 17694720, OFF_PSH = 18219008, OFF_PWKV = 18226176,
                 OFF_SK = 18357248, OFF_SV = 18488320, OFF_SSH = 18619392, OFF_SWKV = 18633728, OUT_TOTAL = 18895872;
constexpr size_t KiB = 1024, MiB = 1u << 20;
constexpr size_t WS_CTL = 0, CTL_ZERO_BYTES = 64 * KiB;
constexpr size_t WS_WIN = 1 * MiB, WS_WOUT = 6 * MiB, WS_WCQ = 8 * MiB, WS_WCO = 9 * MiB, WS_WUP = 10 * MiB, WS_WDN = 18 * MiB, WS_WMKV = 26 * MiB, WS_WLORA = 28 * MiB;
constexpr size_t PART_BYTES = 1114112;
constexpr size_t WS_PART1 = 28 * MiB + 768 * KiB, WS_PART2 = WS_PART1 + PART_BYTES, WS_PART3 = WS_PART2 + PART_BYTES;
constexpr size_t WS_XN = 32 * MiB;
constexpr size_t WS_MN = 64 * MiB + 512 * KiB;
constexpr size_t WS_MKB = 66 * MiB + 512 * KiB, WS_MVB = 69 * MiB + 512 * KiB;
constexpr size_t WS_QKV = 73 * MiB;
constexpr size_t WS_RKV = 97 * MiB + 512 * KiB;
constexpr size_t WS_ZR = 146 * MiB + 256 * KiB;
constexpr size_t WS_LW = WS_ZR, WS_G = 178 * MiB + 768 * KiB;
constexpr size_t WS_AP = 203 * MiB + 256 * KiB;
constexpr size_t WS_AH = 211 * MiB + 512 * KiB;
constexpr size_t WS_XB = 211 * MiB + 512 * KiB;
constexpr size_t WS_H = 73 * MiB;
constexpr size_t WS_GB = 195 * MiB;
constexpr size_t WS_HB = 227 * MiB;
constexpr size_t WS_SB = WS_LW;
constexpr size_t WS_BON = WS_PART3;
constexpr size_t WS_END = 244 * MiB;
static_assert(WS_PART3 + PART_BYTES <= WS_XN && WS_XN + (size_t)MALL * DM * 2 <= WS_MN && WS_MVB + 3 * MiB <= WS_QKV, "ws map 1");
static_assert(WS_QKV + (size_t)MALL * NQKV * 2 <= WS_RKV && WS_RKV + (size_t)MALL * 1536 * 2 <= WS_ZR && WS_ZR + (size_t)MALL * NZR * 2 <= WS_AP, "ws map 2");
static_assert(WS_LW + (size_t)MALL * 512 * 4 <= WS_G && WS_G + (size_t)MALL * 512 * 2 <= WS_AP && WS_AP + (size_t)MALL * 256 * 2 <= WS_AH, "ws map 3");
static_assert(WS_GB >= WS_G + (size_t)MALL * 512 * 2 && WS_GB + 32 * MiB <= WS_HB && WS_HB + 16 * MiB <= WS_END, "ws map 5");
static_assert(WS_XB + (size_t)MALL * DM * 2 <= WS_END && WS_H + (size_t)MALL * DFF * 2 <= WS_AP, "ws map 4");
constexpr size_t DO_QB = (size_t)MALL * 512, DO_AH = DO_QB + (size_t)MP * 256;
static_assert(DO_AH + (size_t)MALL * 256 <= (size_t)MALL * 1024, "d_out scratch map");
constexpr int CW_BAR = 4096;

constexpr int RING_BYTES = 131072, LDSCTL_OFF = RING_BYTES, MISC_OFF = LDSCTL_OFF + 320, LDS_BYTES = 163840;

typedef float f32x16 __attribute__((ext_vector_type(16)));
typedef short bf16x4 __attribute__((ext_vector_type(4)));
typedef unsigned u32x2 __attribute__((ext_vector_type(2)));

__device__ __forceinline__ float bf2f(unsigned short b) { return __uint_as_float((unsigned)b << 16); }
__device__ __forceinline__ float wave_sum(float v) {
#pragma unroll
    for (int o = 1; o < 64; o <<= 1) v += __shfl_xor(v, o);
    return v;
}
__device__ __forceinline__ float sigmoidf_(float x) { return 1.0f / (1.0f + __expf(-x)); }
__device__ __forceinline__ void lds_barrier() { asm volatile("s_waitcnt lgkmcnt(0)" ::: "memory"); __builtin_amdgcn_s_barrier(); asm volatile("" ::: "memory"); }

typedef const float* CFP; typedef __attribute__((address_space(4))) const CFP* InTab;
__device__ __forceinline__ InTab launder_in(InTab p) { asm volatile("" : "+s"(p)); return p; }
#define INP(k) (launder_in(F.in)[k])
struct Frame {
    LAS unsigned char* lds; volatile LAS unsigned* MISC; gu32* ctl;
    int tid, lane, wave, vcu, G;
    InTab in; float* out; unsigned char* ws;
};

__device__ __forceinline__ void p0_transpose_item(const float* W, int K, int N, bf16* WT, int row_off, const float* gk, LAS float* scr, int item, int lane) {
    const int nblk = N / 32, kb = item / nblk, nb = item % nblk, k0 = 64 * kb, n0 = 32 * nb;
#pragma unroll 8
    for (int i = 0; i < 32; ++i) { const int kk = 2 * i + (lane >> 5); float v = W[(size_t)(k0 + kk) * N + n0 + (lane & 31)]; if (gk) v *= gk[k0 + kk]; scr[kk * 33 + (lane & 31)] = v; }
    LDS_WAIT(); asm volatile("" ::: "memory");
    const int c = lane & 7;
#pragma unroll
    for (int j = 0; j < 4; ++j) { const int n = (lane >> 3) + 8 * j; const LAS float* s = scr + (8 * c) * 33 + n;
        v4u o; o.x = pk2(s[0 * 33], s[1 * 33]); o.y = pk2(s[2 * 33], s[3 * 33]); o.z = pk2(s[4 * 33], s[5 * 33]); o.w = pk2(s[6 * 33], s[7 * 33]);
        *(GAS v4u*)(WT + (size_t)(row_off + n0 + n) * K + k0 + 8 * c) = o; }
    LDS_WAIT(); asm volatile("" ::: "memory");
}
__device__ __forceinline__ void rms_row_to_bf16(const float* xrow, const float* g, bf16* orow, int lane) {
    const GAS f32x4* xr = (const GAS f32x4*)xrow + lane; const GAS f32x4* gr = (const GAS f32x4*)g + lane;
    f32x4 v[4]; float s = 0.f;
#pragma unroll
    for (int j = 0; j < 4; ++j) { v[j] = xr[64 * j]; s += (v[j].x * v[j].x + v[j].y * v[j].y) + (v[j].z * v[j].z + v[j].w * v[j].w); }
    const float rstd = 1.0f / sqrtf(wave_sum(s) * (1.f / 1024.f) + NORM_EPS);
    GAS unsigned long long* o8 = (GAS unsigned long long*)orow + lane;
#pragma unroll
    for (int j = 0; j < 4; ++j) { const f32x4 gg = gr[64 * j];
        o8[64 * j] = (unsigned long long)pk2(v[j].x * rstd * gg.x, v[j].y * rstd * gg.y) | ((unsigned long long)pk2(v[j].z * rstd * gg.z, v[j].w * rstd * gg.w) << 32); }
}
__device__ __forceinline__ void p0_prologue(Frame& F) {
    LAS float* scr = (LAS float*)(F.lds + F.wave * 16384);
    const int gw = F.vcu * NWAVES + F.wave, NGW = F.G * NWAVES;
    unsigned char* ws = F.ws;
    constexpr int I_IN = 16 * 80, I_MK = 16 * 16, I_MV = 16 * 16;
    constexpr int NITEMS = I_IN + I_MK + I_MV;
    for (int it = gw; it < NITEMS; it += NGW) {
        int r = it;
        if (r < I_IN) { p0_transpose_item(INP(10), 1024, 2560, (bf16*)(ws + WS_WIN), 0, nullptr, scr, r, F.lane); continue; } r -= I_IN;
        if (r < I_MK) { p0_transpose_item(INP(28), 1024, 512, (bf16*)(ws + WS_WMKV), 0, nullptr, scr, r, F.lane); continue; } r -= I_MK;
        p0_transpose_item(INP(29), 1024, 512, (bf16*)(ws + WS_WMKV), 512, nullptr, scr, r, F.lane);
    }
    {
        bf16* WL = (bf16*)(ws + WS_WLORA); const float* w2 = INP(15); const float* a2 = INP(17); const float* g2 = INP(18);
        const int gt = F.vcu * NTHR + F.tid, NGT = F.G * NTHR;
        for (int idx = gt; idx < 1536 * 256; idx += NGT) {
            const int n = idx >> 8, k = idx & 255; float v = 0.f;
            if (n < 512) { if (k < 64) v = w2[k * 512 + n]; }
            else if (n < 1024) { if (k >= 64 && k < 128) v = a2[(k - 64) * 512 + (n - 512)]; }
            else { if (k >= 128) v = g2[(k - 128) * 512 + (n - 1024)]; }
            WL[idx] = (bf16)f2bf(v);
        }
        const f32x4* ck = (const f32x4*)INP(5); const f32x4* cv = (const f32x4*)INP(6);
        u32x2* mk = (u32x2*)((bf16*)(ws + WS_MKB) + 4 * 256 * 512); u32x2* mv = (u32x2*)((bf16*)(ws + WS_MVB) + 4 * 256 * 512);
        for (int idx = gt; idx < 8 * 256 * 512 / 4; idx += NGT) {
            const f32x4 a = ck[idx], b = cv[idx];
            mk[idx] = (u32x2){pk2(a.x, a.y), pk2(a.z, a.w)}; mv[idx] = (u32x2){pk2(b.x, b.y), pk2(b.z, b.w)};
        }
        const f32x4* ak = (const f32x4*)INP(3); const f32x4* av = (const f32x4*)INP(4);
        f32x4* ok = (f32x4*)(F.out + OFF_SK); f32x4* ov = (f32x4*)(F.out + OFF_SV);
        for (int idx = gt; idx < 8 * 96 * 32; idx += NGT) {
            const int b = idx / (96 * 32), rem = idx % (96 * 32);
            ok[b * 128 * 32 + rem] = ak[b * 128 * 32 + 32 * 32 + rem]; ov[b * 128 * 32 + rem] = av[b * 128 * 32 + 32 * 32 + rem];
        }
    }
    for (int m = gw; m < MALL + 1024; m += NGW) {
        if (m < MALL) { const float* xr = m < MP ? INP(0) + (size_t)m * DM : INP(1) + (size_t)(m - MP) * DM; rms_row_to_bf16(xr, INP(9), (bf16*)(ws + WS_XN) + (size_t)m * DM, F.lane); }
        else { const int r = m - MALL; rms_row_to_bf16(INP(2) + (size_t)r * DM, INP(26), (bf16*)(ws + WS_MN) + (size_t)r * DM, F.lane); }
    }
}

__device__ __forceinline__ void p0_late_weights(Frame& F, int set, int widx, int nw) {
    LAS float* scr = (LAS float*)(F.lds + F.wave * 16384); unsigned char* ws = F.ws;
    constexpr int I_OUT = 16 * 32, I_CQ = 16 * 16, I_CO = 8 * 32, I_UP = 16 * 128, I_DN = 64 * 32;
    if (set == 0) {
        for (int it = widx; it < I_OUT + I_CQ + I_CO; it += nw) { int r = it;
            if (r < I_OUT) { p0_transpose_item(INP(24), 1024, 1024, (bf16*)(ws + WS_WOUT), 0, nullptr, scr, r, F.lane); continue; } r -= I_OUT;
            if (r < I_CQ) { p0_transpose_item(INP(27), 1024, 512, (bf16*)(ws + WS_WCQ), 0, INP(25), scr, r, F.lane); continue; } r -= I_CQ;
            p0_transpose_item(INP(30), 512, 1024, (bf16*)(ws + WS_WCO), 0, nullptr, scr, r, F.lane); }
    } else {
        for (int it = widx; it < I_UP + I_DN; it += nw) { int r = it;
            if (r < I_UP) { p0_transpose_item(INP(32), 1024, 4096, (bf16*)(ws + WS_WUP), 0, INP(31), scr, r, F.lane); continue; } r -= I_UP;
            p0_transpose_item(INP(33), 4096, 1024, (bf16*)(ws + WS_WDN), 0, nullptr, scr, r, F.lane); }
    }
}

#define EPI_ROWS_BEGIN _Pragma("unroll") for (int ai = 0; ai < NAI; ++ai) _Pragma("unroll") for (int m = 0; m < 4; ++m) { const int row = row0 + ai * 128 + m * 16;
#define EPI_ROWS_END }
#define EPI_PG8_CALL __device__ __forceinline__ void operator()(const f32x4 (&acc)[2][2][4][2], const pg8::Unit& u, int wr, int wc, int fr, int fq) const { \
        this->template run<2, 128>(acc, u.pm * 256 + wr * 64 + fr, u.pn * 256 + wc * 32 + 8 * fq, u.pn * 4 + wc, fq); }
__device__ __forceinline__ v4u pack8(const f32x4 a, const f32x4 b) { v4u w; w.x = pg8::cvt_pk_bf16(a[0], a[1]); w.y = pg8::cvt_pk_bf16(a[2], a[3]); w.z = pg8::cvt_pk_bf16(b[0], b[1]); w.w = pg8::cvt_pk_bf16(b[2], b[3]); return w; }

struct EpiIn {
    static constexpr bool PERM = true, AFTER_DRAIN = false;
    bf16* QKV; bf16* ZR; float* out;
    EPI_PG8_CALL
    template <int NAI, int BJS> __device__ __forceinline__ void run(const f32x4 (&acc)[2][2][4][2], int row0, int colt, int slot, int fq) const {
        const int pn = colt >> 8;
        EPI_ROWS_BEGIN
#pragma unroll
            for (int bj = 0; bj < 2; ++bj) { const int col = colt + bj * BJS; const f32x4 v0 = acc[ai][bj][m][0], v1 = acc[ai][bj][m][1];
                const v4u w = pack8(v0, v1);
                if (pn < 3) *(v4u*)(QKV + (size_t)row * NQKV + col) = w; else *(v4u*)(ZR + (size_t)row * NZR + (col - NQKV)) = w;
                float* dst = nullptr;
                if (pn == 2) { const int cc = col - 512, kv = cc >> 7, c7 = cc & 127;
                    if (row < MP) { const int t = row & 4095; if (t >= 3968) dst = out + (kv ? OFF_PV : OFF_PK) + ((size_t)((row >> 12) * 128 + (t - 3968))) * 128 + c7; }
                    else { const int rs = row - MP; dst = out + (kv ? OFF_SV : OFF_SK) + ((size_t)((rs >> 5) * 128 + 96 + (rs & 31))) * 128 + c7; } }
                else if (pn >= 3) { const int zc = col - NQKV;
                    if (row < MP) { if ((row & 4095) == 4095) dst = out + OFF_PSH + (size_t)(row >> 12) * NZR + zc; }
                    else { const int rs = row - MP; if ((rs & 31) == 31) dst = out + OFF_SSH + (size_t)(rs >> 5) * NZR + zc; } }
                if (dst) { *(f32x4*)dst = v0; *(f32x4*)(dst + 4) = v1; } }
        EPI_ROWS_END
    }
};
struct EpiMemKV {
    static constexpr bool PERM = true, AFTER_DRAIN = false;
    bf16* MKB; bf16* MVB; float* out;
    EPI_PG8_CALL
    template <int NAI, int BJS> __device__ __forceinline__ void run(const f32x4 (&acc)[2][2][4][2], int row0, int colt, int slot, int fq) const {
        EPI_ROWS_BEGIN
#pragma unroll
            for (int bj = 0; bj < 2; ++bj) { const int col = colt + bj * BJS; const f32x4 v0 = acc[ai][bj][m][0], v1 = acc[ai][bj][m][1];
                const int kv = col >> 9, c = col & 511;
                float* dst = out + (kv ? OFF_PMV : OFF_PMK) + (size_t)row * 512 + c; *(f32x4*)dst = v0; *(f32x4*)(dst + 4) = v1;
                *(v4u*)((kv ? MVB : MKB) + (size_t)row * 512 + c) = pack8(v0, v1); }
        EPI_ROWS_END
    }
};
struct EpiLora {
    static constexpr bool PERM = true, AFTER_DRAIN = false;
    float* LW; bf16* AH; bf16* Gg; const float* w0; const float* a0;
    EPI_PG8_CALL
    template <int NAI, int BJS> __device__ __forceinline__ void run(const f32x4 (&acc)[2][2][4][2], int row0, int colt, int slot, int fq) const {
        const int sel = colt >> 9;
        const float* bias = sel == 0 ? w0 : a0; const float mul = sel == 0 ? -0.6065306597f : 1.0f;
        EPI_ROWS_BEGIN
#pragma unroll
            for (int bj = 0; bj < 2; ++bj) { const int c = (colt + bj * BJS) & 511; f32x4 v0 = acc[ai][bj][m][0], v1 = acc[ai][bj][m][1];
                if (sel < 2) {
#pragma unroll
                    for (int e = 0; e < 4; ++e) { v0[e] = mul * sigmoidf_(v0[e] + bias[c + e]); v1[e] = mul * sigmoidf_(v1[e] + bias[c + 4 + e]); } }
                if (sel == 0) { float* dst = LW + (size_t)row * 512 + c; *(f32x4*)dst = v0; *(f32x4*)(dst + 4) = v1; }
                else *(v4u*)((sel == 1 ? AH : Gg) + (size_t)row * 512 + c) = pack8(v0, v1); }
        EPI_ROWS_END
    }
};
struct EpiRes {
    static constexpr bool PERM = true, AFTER_DRAIN = false;
    const float* resP; const float* resS; const bf16* RB; float* out; bf16* XB; float* PART;
    EPI_PG8_CALL
    template <int NAI, int BJS> __device__ __forceinline__ void run(const f32x4 (&acc)[2][2][4][2], int row0, int colt, int slot, int fq) const {
        EPI_ROWS_BEGIN
            float ss = 0.f;
#pragma unroll
            for (int bj = 0; bj < 2; ++bj) { const int col = colt + bj * BJS; f32x4 r0, r1;
                if (RB) { const v4u rb = *(const v4u*)(RB + (size_t)row * DM + col);
                    r0 = (f32x4){__uint_as_float(rb.x << 16), __uint_as_float(rb.x & 0xffff0000u), __uint_as_float(rb.y << 16), __uint_as_float(rb.y & 0xffff0000u)};
                    r1 = (f32x4){__uint_as_float(rb.z << 16), __uint_as_float(rb.z & 0xffff0000u), __uint_as_float(rb.w << 16), __uint_as_float(rb.w & 0xffff0000u)}; }
                else { const float* rp = row < MP ? resP + (size_t)row * DM : resS + (size_t)(row - MP) * DM; r0 = *(const f32x4*)(rp + col); r1 = *(const f32x4*)(rp + col + 4); }
                const f32x4 v0 = acc[ai][bj][m][0] + r0, v1 = acc[ai][bj][m][1] + r1;
                if (out) { float* dst = out + (size_t)row * DM + col; *(f32x4*)dst = v0; *(f32x4*)(dst + 4) = v1; }
                if (XB) *(v4u*)(XB + (size_t)row * DM + col) = pack8(v0, v1);
                ss += (v0[0] * v0[0] + v0[1] * v0[1]) + (v0[2] * v0[2] + v0[3] * v0[3]) + (v1[0] * v1[0] + v1[1] * v1[1]) + (v1[2] * v1[2] + v1[3] * v1[3]); }
            ss += __shfl_xor(ss, 16); ss += __shfl_xor(ss, 32);
            if (fq == 0) PART[(size_t)row * 16 + slot] = ss;
        EPI_ROWS_END
    }
};
template <int ACT  > struct EpiNormBf16 {
    static constexpr bool PERM = true, AFTER_DRAIN = false;
    bf16* O; int ldc; const float* PART; float scale;
    EPI_PG8_CALL
    template <int NAI, int BJS> __device__ __forceinline__ void run(const f32x4 (&acc)[2][2][4][2], int row0, int colt, int slot, int fq) const {
        EPI_ROWS_BEGIN
            const f32x4 pp = *(const f32x4*)(PART + (size_t)row * 16 + 4 * fq); float ss = (pp[0] + pp[1]) + (pp[2] + pp[3]);
            ss += __shfl_xor(ss, 16); ss += __shfl_xor(ss, 32);
            const float rs = scale / sqrtf(ss * (1.f / 1024.f) + NORM_EPS);
#pragma unroll
            for (int bj = 0; bj < 2; ++bj) { const int col = colt + bj * BJS; f32x4 v0 = acc[ai][bj][m][0] * rs, v1 = acc[ai][bj][m][1] * rs;
                if (ACT == 1) {
#pragma unroll
                    for (int e = 0; e < 4; ++e) { const float a = fmaxf(v0[e], 0.f), b = fmaxf(v1[e], 0.f); v0[e] = a * a; v1[e] = b * b; } }
                *(v4u*)(O + (size_t)row * ldc + col) = pack8(v0, v1); }
        EPI_ROWS_END
    }
};

template <class Epi> __device__ __forceinline__ void small_gemm(Frame& F, const bf16* A, const bf16* Bt, int K, int N, const Epi& E) {
    const int ntile = 4 * (N / 64), lane = F.lane, wave = F.wave, fr = lane & 15, fq = lane >> 4;
    const int bx = (int)blockIdx.x;
    LAS f32x4* red = (LAS f32x4*)F.lds;
    for (int t = F.G - 1 - bx; t < ntile; t += F.G) {
        const int rowbase = MP + 64 * (t & 3), colbase = 64 * (t >> 2);
        f32x4 acc[2][2][4][2];
#pragma unroll
        for (int bj = 0; bj < 2; ++bj)
#pragma unroll
            for (int m = 0; m < 4; ++m)
#pragma unroll
                for (int n = 0; n < 2; ++n) { acc[0][bj][m][n] = (f32x4){0.f, 0.f, 0.f, 0.f}; acc[1][bj][m][n] = (f32x4){0.f, 0.f, 0.f, 0.f}; }
        const int kslice = K >> 3, kbeg = wave * kslice;
        const bf16* ap = A + (size_t)(rowbase + fr) * K + kbeg + 8 * fq;
        const bf16* bp = Bt + (size_t)(colbase + 8 * (fr >> 2) + (fr & 3)) * K + kbeg + 8 * fq;
#pragma unroll 2
        for (int k0 = 0; k0 < kslice; k0 += 32) {
            bf16x8 af[4], wf[2][2];
#pragma unroll
            for (int m = 0; m < 4; ++m) af[m] = *(const bf16x8*)(ap + (size_t)(16 * m) * K + k0);
#pragma unroll
            for (int bj = 0; bj < 2; ++bj)
#pragma unroll
                for (int n = 0; n < 2; ++n) wf[bj][n] = *(const bf16x8*)(bp + (size_t)(32 * bj + 4 * n) * K + k0);
#pragma unroll
            for (int bj = 0; bj < 2; ++bj)
#pragma unroll
                for (int m = 0; m < 4; ++m)
#pragma unroll
                    for (int n = 0; n < 2; ++n) acc[0][bj][m][n] = __builtin_amdgcn_mfma_f32_16x16x32_bf16(wf[bj][n], af[m], acc[0][bj][m][n], 0, 0, 0);
        }
#pragma unroll
        for (int step = 4; step >= 1; step >>= 1) {
            lds_barrier();
            if (wave >= step && wave < 2 * step) {
#pragma unroll
                for (int bj = 0; bj < 2; ++bj)
#pragma unroll
                    for (int m = 0; m < 4; ++m)
#pragma unroll
                        for (int n = 0; n < 2; ++n) red[((wave - step) * 16 + (bj * 8 + m * 2 + n)) * 64 + lane] = acc[0][bj][m][n]; }
            lds_barrier();
            if (wave < step) {
#pragma unroll
                for (int bj = 0; bj < 2; ++bj)
#pragma unroll
                    for (int m = 0; m < 4; ++m)
#pragma unroll
                        for (int n = 0; n < 2; ++n) acc[0][bj][m][n] += red[(wave * 16 + (bj * 8 + m * 2 + n)) * 64 + lane]; }
        }
        if (wave == 0) E.template run<1, 32>(acc, rowbase + fr, colbase + 8 * fq, colbase >> 6, fq);
    }
    lds_barrier();
}

__device__ __forceinline__ void p2_prep(Frame& F) {
    const int gw = F.vcu * NWAVES + F.wave, NGW = F.G * NWAVES;
    const bf16* ZR = (const bf16*)(F.ws + WS_ZR); bf16* RKV = (bf16*)(F.ws + WS_RKV); bf16* AP = (bf16*)(F.ws + WS_AP);
    const float* mu = INP(13); const float* sshift = INP(7);
    for (int m = gw; m < MALL; m += NGW) {
        const int t = m < MP ? (m & 4095) : ((m - MP) & 31);
        for (int ch = F.lane; ch < NZR / 8; ch += 64) {
            const int col = ch * 8;
            const v4u cu = *(const v4u*)(ZR + (size_t)m * NZR + col);
            float cur[8], prv[8];
#pragma unroll
            for (int e = 0; e < 4; ++e) { cur[2 * e] = __uint_as_float(cu[e] << 16); cur[2 * e + 1] = __uint_as_float(cu[e] & 0xffff0000u); }
            if (t > 0) { const v4u pu = *(const v4u*)(ZR + (size_t)(m - 1) * NZR + col);
#pragma unroll
                for (int e = 0; e < 4; ++e) { prv[2 * e] = __uint_as_float(pu[e] << 16); prv[2 * e + 1] = __uint_as_float(pu[e] & 0xffff0000u); } }
            else if (m >= MP) { const float* sp = sshift + (size_t)((m - MP) >> 5) * NZR + col;
#pragma unroll
                for (int e = 0; e < 8; ++e) prv[e] = sp[e]; }
            else {
#pragma unroll
                for (int e = 0; e < 8; ++e) prv[e] = 0.f; }
            float zs[8];
#pragma unroll
            for (int e = 0; e < 8; ++e) zs[e] = cur[e] + (prv[e] - cur[e]) * mu[col + e];
            if (col >= 1536) {
                if (col < 1600) {
#pragma unroll
                    for (int e = 0; e < 8; ++e) zs[e] = tanhf(zs[e]); }
                else if (col >= 1664) {
#pragma unroll
                    for (int e = 0; e < 8; ++e) zs[e] = sigmoidf_(zs[e]); }
            }
            v4u w; w.x = pk2(zs[0], zs[1]); w.y = pk2(zs[2], zs[3]); w.z = pk2(zs[4], zs[5]); w.w = pk2(zs[6], zs[7]);
            if (col < 1536) *(v4u*)(RKV + (size_t)m * 1536 + col) = w; else *(v4u*)(AP + (size_t)m * 256 + (col - 1536)) = w;
        }
    }
}

constexpr int CK_STR = 144;
constexpr int CK_AT = 0, CK_BT = 9216, CK_KT = 18432, CK_RT = 27648, CK_VT = 36864, CK_BPT = 46080, CK_KPT = 55296, CK_MAK = 64512, CK_MRB = 73728, CK_MRK = 82944,
              CK_L = 92160  , CK_X = 108544  , CK_DC = 125952  , CK_TOT = 126208  ;
constexpr int CK_X2 = 131584;
constexpr int CK_TINV = CK_X2 + 17408;
static_assert(CK_X2 >= MISC_OFF + 128 && CK_TINV + 4096 <= LDS_BYTES, "chunk LDS map 2");
constexpr int CK_SA0T = CK_MAK, CK_PT = CK_L;
static_assert(CK_TOT + 2048 <= RING_BYTES, "chunk LDS map");
__device__ __forceinline__ float allreduce16(float v) {
    v += __int_as_float(__builtin_amdgcn_update_dpp(0, __float_as_int(v), 0xB1, 0xf, 0xf, false));
    v += __int_as_float(__builtin_amdgcn_update_dpp(0, __float_as_int(v), 0x4E, 0xf, 0xf, false));
    v += __int_as_float(__builtin_amdgcn_update_dpp(0, __float_as_int(v), 0x141, 0xf, 0xf, false));
    v += __int_as_float(__builtin_amdgcn_update_dpp(0, __float_as_int(v), 0x140, 0xf, 0xf, false));
    return v;
}
__device__ __forceinline__ float wave_sum_fast(float v) {
    const int a = __float_as_int(allreduce16(v));
    return (__int_as_float(__builtin_amdgcn_readlane(a, 0)) + __int_as_float(__builtin_amdgcn_readlane(a, 16))) + (__int_as_float(__builtin_amdgcn_readlane(a, 32)) + __int_as_float(__builtin_amdgcn_readlane(a, 48)));
}
__device__ __forceinline__ void mm64(const LAS unsigned char* Am, const LAS unsigned char* Bm, f32x4 (&acc)[2], int wave, int lane) {
    const int mt = wave >> 1, fr = lane & 15, fq = lane >> 4;
#pragma unroll
    for (int ks = 0; ks < 2; ++ks) { const bf16x8 af = *(const LAS bf16x8*)(Am + (16 * mt + fr) * CK_STR + (32 * ks + 8 * fq) * 2);
#pragma unroll
        for (int q = 0; q < 2; ++q) { const bf16x8 bfr = *(const LAS bf16x8*)(Bm + (16 * (2 * (wave & 1) + q) + fr) * CK_STR + (32 * ks + 8 * fq) * 2);
            acc[q] = __builtin_amdgcn_mfma_f32_16x16x32_bf16(af, bfr, acc[q], 0, 0, 0); } }
}
#define CK_ZERO(acc) do { acc[0] = (f32x4){0.f, 0.f, 0.f, 0.f}; acc[1] = (f32x4){0.f, 0.f, 0.f, 0.f}; } while (0)
struct CkRaw { float gr[8], gk[8], gv[8], gl[8], ga[8]; };
__device__ __forceinline__ void ck_prefetch(Frame& F, int job, CkRaw& R) {
    const int bh = job >> 6, cc = job & 63, b = bh >> 3, h = bh & 7, m0 = b * 4096 + cc * 64, hc = h * 64 + F.lane;
    const bf16* RKV = (const bf16*)(F.ws + WS_RKV); const float* LW = (const float*)(F.ws + WS_LW); const bf16* AH = (const bf16*)(F.out + DO_AH);
#pragma unroll
    for (int q = 0; q < 8; ++q) { const size_t mm = (size_t)(m0 + 8 * F.wave + q);
        R.gr[q] = bf2f(RKV[mm * 1536 + hc]); R.gk[q] = bf2f(RKV[mm * 1536 + 512 + hc]); R.gv[q] = bf2f(RKV[mm * 1536 + 1024 + hc]); R.gl[q] = LW[mm * 512 + hc]; R.ga[q] = bf2f(AH[mm * 512 + hc]); }
}
__device__ __forceinline__ void p4_chunk_job(Frame& F, int job, CkRaw& R, int jobnext) {
    const int bh = job >> 6, cc = job & 63, b = bh >> 3, h = bh & 7, m0 = b * 4096 + cc * 64;
    const int lane = F.lane, wave = F.wave, tid = F.tid, hc = h * 64 + lane;
    LAS unsigned char* lds = F.lds;
    float* BON = (float*)(F.ws + WS_BON); float* Yraw = F.out; bf16* QB = (bf16*)(F.out + DO_QB);
    float* GB = (float*)(F.ws + WS_GB) + (size_t)job * 4096; bf16* HB = (bf16*)(F.ws + WS_HB) + (size_t)job * 4096;
    lds_barrier();
    {
        const float kkw = INP(19)[hc], kaw = INP(20)[hc], rkw = INP(21)[hc];
        float gr[8], gk[8], gv[8], gl[8], ga[8], cum[8];
#pragma unroll
        for (int q = 0; q < 8; ++q) { gr[q] = R.gr[q]; gk[q] = R.gk[q]; gv[q] = R.gv[q]; gl[q] = R.gl[q]; ga[q] = R.ga[q]; }
        float run = 0.f;
#pragma unroll
        for (int q = 0; q < 8; ++q) { run += gl[q]; cum[q] = run; }
        LAS float* tot = (LAS float*)(lds + CK_TOT);
        tot[wave * 64 + lane] = run;
        lds_barrier();
        float off = 0.f, cumC = 0.f;
#pragma unroll
        for (int w2 = 0; w2 < 8; ++w2) { const float tv = tot[w2 * 64 + lane]; cumC += tv; if (w2 < wave) off += tv; }
        if (wave == 0) ((LAS float*)(lds + CK_DC))[lane] = __expf(cumC);
#pragma unroll
        for (int q = 0; q < 8; ++q) { const int t = 8 * wave + q; const float cu = off + cum[q];
            float kk = gk[q] * kkw; const float n2 = wave_sum_fast(kk * kk); kk = kk / fmaxf(sqrtf(n2), 1e-12f);
            const float kp = gk[q] * (1.0f + (ga[q] - 1.0f) * kaw); const float bon = wave_sum_fast(gr[q] * kp * rkw);
            const float av = -kk, bv = kk * ga[q];
            const float e1 = __expf(cu - gl[q]), e2 = __expf(-cu), e3 = __expf(cu), e4 = __expf(cumC - cu);
            *(LAS float*)(lds + CK_X2 + (lane * 68 + t) * 4) = av * e1;
            *(LAS bf16*)(lds + CK_AT + t * CK_STR + lane * 2) = (bf16)f2bf(av * e1); *(LAS bf16*)(lds + CK_BT + t * CK_STR + lane * 2) = (bf16)f2bf(bv * e2);
            *(LAS bf16*)(lds + CK_KT + t * CK_STR + lane * 2) = (bf16)f2bf(kp * e2); *(LAS bf16*)(lds + CK_RT + t * CK_STR + lane * 2) = (bf16)f2bf(gr[q] * e3);
            *(LAS bf16*)(lds + CK_VT + lane * CK_STR + t * 2) = (bf16)f2bf(gv[q]); *(LAS bf16*)(lds + CK_BPT + lane * CK_STR + t * 2) = (bf16)f2bf(bv * e4);
            *(LAS bf16*)(lds + CK_KPT + lane * CK_STR + t * 2) = (bf16)f2bf(kp * e4);
            if (lane == 0) BON[(size_t)(m0 + t) * 8 + h] = bon; }
    }
    lds_barrier();
    const int fr = lane & 15, fq = lane >> 4, mt = wave >> 1;
    f32x4 acc[2];
#define CK_STORE_TS(img, strict) do { _Pragma("unroll") for (int q = 0; q < 2; ++q) { const int n = 16 * (2 * (wave & 1) + q) + fr, mb_ = 16 * mt + 4 * fq; float o_[4]; \
        _Pragma("unroll") for (int e = 0; e < 4; ++e) o_[e] = ((strict) ? (mb_ + e < n) : (mb_ + e <= n)) ? acc[q][e] : 0.f; \
        u32x2 w_; w_.x = pg8::cvt_pk_bf16(o_[0], o_[1]); w_.y = pg8::cvt_pk_bf16(o_[2], o_[3]); *(LAS u32x2*)(lds + (img) + n * CK_STR + mb_ * 2) = w_; } } while (0)
    CK_ZERO(acc); mm64(lds + CK_KT, lds + CK_AT, acc, wave, lane); CK_STORE_TS(CK_MAK, true);
    CK_ZERO(acc); mm64(lds + CK_BT, lds + CK_RT, acc, wave, lane); CK_STORE_TS(CK_MRB, false);
    CK_ZERO(acc); mm64(lds + CK_KT, lds + CK_RT, acc, wave, lane); CK_STORE_TS(CK_MRK, false);
    CK_ZERO(acc); mm64(lds + CK_BT, lds + CK_AT, acc, wave, lane);
#pragma unroll
    for (int q = 0; q < 2; ++q) { const int n = 16 * (2 * (wave & 1) + q) + fr, mb_ = 16 * mt + 4 * fq; f32x4 o;
#pragma unroll
        for (int e = 0; e < 4; ++e) o[e] = (mb_ + e < n) ? acc[q][e] : 0.f;
        *(LAS f32x4*)(lds + CK_L + (n * 64 + mb_) * 4) = o; }
    lds_barrier();
    {
        const int cl = lane & 15;
        if (wave < 4) {
            int zoff = 0; asm volatile("" : "+v"(zoff));
            const LAS float* Lb = (const LAS float*)(lds + CK_L) + (16 * wave) * 64 + 16 * wave + zoff;
            LAS float* Tinv = (LAS float*)(lds + CK_TINV);
            f32x4 lr[15][4];
#pragma unroll
            for (int tt = 1; tt < 16; ++tt)
#pragma unroll
                for (int s4 = 0; s4 < (tt + 3) / 4; ++s4) lr[tt - 1][s4] = *(const LAS f32x4*)(Lb + tt * 64 + 4 * s4);
            __builtin_amdgcn_sched_barrier(0);
            float z[16];
#pragma unroll
            for (int tt = 0; tt < 16; ++tt) z[tt] = (tt == cl) ? 1.f : 0.f;
#pragma unroll
            for (int tt = 1; tt < 16; ++tt) { float a0 = z[tt], a1 = 0.f;
#pragma unroll
                for (int s4 = 0; s4 < (tt + 3) / 4; ++s4) { const f32x4 l4 = lr[tt - 1][s4]; a0 += l4[0] * z[4 * s4]; a1 += l4[1] * z[4 * s4 + 1]; a0 += l4[2] * z[4 * s4 + 2]; a1 += l4[3] * z[4 * s4 + 3]; }
                z[tt] = a0 + a1; }
            if (lane < 16) {
#pragma unroll
                for (int tt = 0; tt < 16; ++tt) Tinv[wave * 256 + tt * 16 + cl] = z[tt]; }
        }
    }
    CK_ZERO(acc); mm64(lds + CK_MAK, lds + CK_VT, acc, wave, lane);
#pragma unroll
    for (int q = 0; q < 2; ++q) { const int n = 16 * (2 * (wave & 1) + q) + fr, mb_ = 16 * mt + 4 * fq; *(LAS f32x4*)(lds + CK_X + (n * 68 + mb_) * 4) = acc[q]; }
    lds_barrier();
    ck_prefetch(F, jobnext, R);
    {
        const LAS float* Lp = (const LAS float*)(lds + CK_L);
        const LAS float* Tinv = (const LAS float*)(lds + CK_TINV);
        const int cl = lane & 15;
        LAS float* xcol = (LAS float*)(lds + (wave < 4 ? CK_X + (16 * wave + cl) * 272 : CK_X2 + (16 * (wave - 4) + cl) * 272));
#pragma unroll
        for (int tb = 0; tb < 4; ++tb) {
            if (tb > 0) {
                f32x4 ua = *(LAS f32x4*)(xcol + 16 * tb + 4 * fq);
#pragma unroll
                for (int ks = 0; ks < 4 * tb; ++ks) ua = __builtin_amdgcn_mfma_f32_16x16x4f32(Lp[(16 * tb + cl) * 64 + 4 * ks + fq], xcol[4 * ks + fq], ua, 0, 0, 0);
                *(LAS f32x4*)(xcol + 16 * tb + 4 * fq) = ua;
            }
            f32x4 ya = (f32x4){0.f, 0.f, 0.f, 0.f};
#pragma unroll
            for (int ks = 0; ks < 4; ++ks) ya = __builtin_amdgcn_mfma_f32_16x16x4f32(Tinv[tb * 256 + cl * 16 + 4 * ks + fq], xcol[16 * tb + 4 * ks + fq], ya, 0, 0, 0);
            *(LAS f32x4*)(xcol + 16 * tb + 4 * fq) = ya;
        }
    }
    lds_barrier();
    for (int idx = tid; idx < 2 * 64 * 8; idx += NTHR) {
        const int which = idx >> 9, row = (idx >> 3) & 63, c8 = idx & 7; const LAS float* src = (const LAS float*)(lds + (which ? CK_X2 : CK_X) + row * 272 + c8 * 32);
        const f32x4 v0 = *(const LAS f32x4*)src, v1 = *(const LAS f32x4*)(src + 4);
        *(LAS v4u*)(lds + (which ? CK_PT : CK_SA0T) + row * CK_STR + c8 * 16) = pack8(v0, v1); }
    lds_barrier();
    {
        CK_ZERO(acc); mm64(lds + CK_PT, lds + CK_MRB, acc, wave, lane);
#pragma unroll
        for (int q = 0; q < 2; ++q) { const int n = 16 * (2 * (wave & 1) + q) + fr, mb_ = 16 * mt + 4 * fq;
            const u32x2 rr = *(const LAS u32x2*)(lds + CK_RT + n * CK_STR + mb_ * 2);
            const float o0 = acc[q][0] + __uint_as_float(rr.x << 16), o1 = acc[q][1] + __uint_as_float(rr.x & 0xffff0000u), o2 = acc[q][2] + __uint_as_float(rr.y << 16), o3 = acc[q][3] + __uint_as_float(rr.y & 0xffff0000u);
            u32x2 w; w.x = pg8::cvt_pk_bf16(o0, o1); w.y = pg8::cvt_pk_bf16(o2, o3); *(u32x2*)(QB + (size_t)(m0 + n) * 512 + h * 64 + mb_) = w; }
    }
    {
        CK_ZERO(acc); mm64(lds + CK_SA0T, lds + CK_MRB, acc, wave, lane); mm64(lds + CK_VT, lds + CK_MRK, acc, wave, lane);
#pragma unroll
        for (int q = 0; q < 2; ++q) { const int n = 16 * (2 * (wave & 1) + q) + fr, mb_ = 16 * mt + 4 * fq; *(f32x4*)(Yraw + (size_t)(m0 + n) * 512 + h * 64 + mb_) = acc[q]; }
    }
    {
        CK_ZERO(acc); mm64(lds + CK_BPT, lds + CK_PT, acc, wave, lane);
        const LAS float* dcp = (const LAS float*)(lds + CK_DC);
#pragma unroll
        for (int q = 0; q < 2; ++q) { const int n = 16 * (2 * (wave & 1) + q) + fr, mb_ = 16 * mt + 4 * fq; f32x4 o = acc[q]; const float dn = dcp[n];
#pragma unroll
            for (int e = 0; e < 4; ++e) if (mb_ + e == n) o[e] += dn;
            *(f32x4*)(GB + n * 64 + mb_) = o; }
    }
    {
        CK_ZERO(acc); mm64(lds + CK_BPT, lds + CK_SA0T, acc, wave, lane); mm64(lds + CK_KPT, lds + CK_VT, acc, wave, lane);
#pragma unroll
        for (int q = 0; q < 2; ++q) { const int n = 16 * (2 * (wave & 1) + q) + fr, mb_ = 16 * mt + 4 * fq;
            u32x2 w; w.x = pg8::cvt_pk_bf16(acc[q][0], acc[q][1]); w.y = pg8::cvt_pk_bf16(acc[q][2], acc[q][3]); *(u32x2*)(HB + n * 64 + mb_) = w; }
    }
#undef CK_STORE_TS
}
constexpr int SC_TT = 32;
constexpr int SC_BUF_FLOATS = 6 * SC_TT * 64;
__device__ __forceinline__ void p4_sample_scan_job(Frame& F, int bh) {
    const int b = bh >> 3, h = bh & 7; const int m0 = MP + b * 32;
    const bf16* RKV = (const bf16*)(F.ws + WS_RKV); const float* LW = (const float*)(F.ws + WS_LW); const bf16* AH = (const bf16*)(F.out + DO_AH);
    float* BON = (float*)(F.ws + WS_BON); float* Yo = F.out;
    LAS float* Lb = (LAS float*)F.lds;
    const int lane = F.lane, wave = F.wave, hc = h * 64 + lane;
    const float kkw = INP(19)[hc], kaw = INP(20)[hc], rkw = INP(21)[hc];
    const int rs = lane >> 4, jq = lane & 15, i0 = 8 * wave + rs, i1 = i0 + 4;
    float S0, S1, S2, S3, U0, U1, U2, U3;
    { const float* st = INP(8) + ((size_t)(bh * 64)) * 64 + 4 * jq; const f32x4 s = *(const f32x4*)(st + (size_t)i0 * 64), u = *(const f32x4*)(st + (size_t)i1 * 64);
      S0 = s[0]; S1 = s[1]; S2 = s[2]; S3 = s[3]; U0 = u[0]; U1 = u[1]; U2 = u[2]; U3 = u[3]; }
    lds_barrier();
#pragma unroll
    for (int q = 0; q < 4; ++q) { const int s = 4 * wave + q; const size_t mm = (size_t)(m0 + s);
        const float gr = bf2f(RKV[mm * 1536 + hc]), gk = bf2f(RKV[mm * 1536 + 512 + hc]), gv = bf2f(RKV[mm * 1536 + 1024 + hc]), gl = LW[mm * 512 + hc], ga = bf2f(AH[mm * 512 + hc]);
        float kk = gk * kkw; const float n2 = wave_sum_fast(kk * kk); kk = kk / fmaxf(sqrtf(n2), 1e-12f);
        const float kp = gk * (1.0f + (ga - 1.0f) * kaw); const float bon = wave_sum_fast(gr * kp * rkw);
        Lb[s * 64 + lane] = __expf(gl); Lb[2048 + s * 64 + lane] = -kk; Lb[4096 + s * 64 + lane] = kk * ga; Lb[6144 + s * 64 + lane] = kp; Lb[8192 + s * 64 + lane] = gr; Lb[10240 + s * 64 + lane] = gv;
        if (lane == 0) BON[(size_t)(m0 + s) * 8 + h] = bon; }
    lds_barrier();
    float ykeep = 0.f, zkeep = 0.f;
#pragma unroll 4
    for (int s = 0; s < SC_TT; ++s) {
        const LAS float* q_ = Lb + s * 64 + 4 * jq;
        const f32x4 w4 = *(const LAS f32x4*)q_, a4 = *(const LAS f32x4*)(q_ + 2048), b4 = *(const LAS f32x4*)(q_ + 4096), k4 = *(const LAS f32x4*)(q_ + 6144), r4 = *(const LAS f32x4*)(q_ + 8192);
        const float v = Lb[10240 + s * 64 + i0], u = Lb[10240 + s * 64 + i1];
        const float sa = allreduce16((S0 * a4[0] + S1 * a4[1]) + (S2 * a4[2] + S3 * a4[3])), ua = allreduce16((U0 * a4[0] + U1 * a4[1]) + (U2 * a4[2] + U3 * a4[3]));
        S0 = S0 * w4[0] + (sa * b4[0] + v * k4[0]); S1 = S1 * w4[1] + (sa * b4[1] + v * k4[1]); S2 = S2 * w4[2] + (sa * b4[2] + v * k4[2]); S3 = S3 * w4[3] + (sa * b4[3] + v * k4[3]);
        U0 = U0 * w4[0] + (ua * b4[0] + u * k4[0]); U1 = U1 * w4[1] + (ua * b4[1] + u * k4[1]); U2 = U2 * w4[2] + (ua * b4[2] + u * k4[2]); U3 = U3 * w4[3] + (ua * b4[3] + u * k4[3]);
        const float y = allreduce16((S0 * r4[0] + S1 * r4[1]) + (S2 * r4[2] + S3 * r4[3])), z = allreduce16((U0 * r4[0] + U1 * r4[1]) + (U2 * r4[2] + U3 * r4[3]));
        ykeep = (jq == (s & 15)) ? y : ykeep; zkeep = (jq == (s & 15)) ? z : zkeep;
        if ((s & 15) == 15) { float* yp = Yo + (size_t)(m0 + (s & 16) + jq) * 512 + h * 64; yp[i0] = ykeep; yp[i1] = zkeep; }
    }
    float* so = F.out + OFF_SWKV + (size_t)bh * 4096;
    *(f32x4*)(so + (size_t)i0 * 64 + 4 * jq) = (f32x4){S0, S1, S2, S3}; *(f32x4*)(so + (size_t)i1 * 64 + 4 * jq) = (f32x4){U0, U1, U2, U3};
}
constexpr int CH_SLOT = 20480  , CH_NSLOT = 6, CH_RING = 4608  , CH_AHEAD = 5;
static_assert(CH_RING + CH_NSLOT * CH_SLOT <= RING_BYTES, "chain LDS map");
#define CH_WAITV(n) asm volatile("s_waitcnt vmcnt(" #n ")" ::: "memory")
__device__ __forceinline__ void p5_chain_job(Frame& F, int job) {
    const int bh = job >> 2, ig = job & 3, lane = F.lane, wave = F.wave, fr = lane & 15, fq = lane >> 4;
    const unsigned char* GBb = (const unsigned char*)((const float*)(F.ws + WS_GB) + (size_t)bh * 64 * 4096);
    const unsigned char* HBb = (const unsigned char*)((const bf16*)(F.ws + WS_HB) + (size_t)bh * 64 * 4096 + (size_t)(16 * ig) * 64);
    bf16* SB = (bf16*)(F.ws + WS_SB) + (size_t)bh * 64 * 4096; float* pw = F.out + OFF_PWKV + (size_t)bh * 4096;
    LAS unsigned char* lds = F.lds; LAS float* Sl = (LAS float*)lds;
    lds_barrier();
    for (int idx = F.tid; idx < 16 * 65; idx += NTHR) Sl[idx] = 0.f;
    if (wave >= 4) {
        const int w4 = wave - 4;
#define CH_ISSUE(c_) do { const int sl_ = (c_) % CH_NSLOT; LAS unsigned char* sb_ = lds + CH_RING + sl_ * CH_SLOT; const unsigned char* gs_ = GBb + (size_t)(c_) * 16384 + w4 * 4096 + lane * 16; \
        _Pragma("unroll") for (int p_ = 0; p_ < 4; ++p_) __builtin_amdgcn_global_load_lds((const unsigned*)(gs_ + p_ * 1024), (LAS unsigned*)(sb_ + w4 * 4096 + p_ * 1024), 16, 0, 0); \
        __builtin_amdgcn_global_load_lds((const unsigned*)(HBb + (size_t)(c_) * 8192 + (w4 & 1) * 1024 + lane * 16), (LAS unsigned*)(sb_ + 16384 + w4 * 1024), 16, 0, 0); } while (0)
        CH_ISSUE(0); CH_ISSUE(1); CH_ISSUE(2); CH_ISSUE(3); CH_ISSUE(4);
        CH_WAITV(20);
        lds_barrier();
        for (int c = 0; c < 64; ++c) {
            if (c + CH_AHEAD < 64) { CH_ISSUE(c + CH_AHEAD); CH_WAITV(20); }
            else CH_WAITV(0);
            lds_barrier();
            lds_barrier();
        }
#undef CH_ISSUE
    } else {
        const int jc = 16 * wave + fr;
        lds_barrier();
        for (int c = 0; c < 64; ++c) {
            const LAS unsigned char* sb = lds + CH_RING + (c % CH_NSLOT) * CH_SLOT;
            float av[16], gv[16];
#pragma unroll
            for (int ks = 0; ks < 16; ++ks) { av[ks] = Sl[fr * 65 + 4 * ks + fq]; gv[ks] = *(const LAS float*)(sb + ((4 * ks + fq) * 64 + jc) * 4); }
            f32x4 acc, acc2 = (f32x4){0.f, 0.f, 0.f, 0.f};
#pragma unroll
            for (int e = 0; e < 4; ++e) acc[e] = bf2f(*(const LAS bf16*)(sb + 16384 + ((4 * fq + e) * 64 + jc) * 2));
            __builtin_amdgcn_sched_barrier(0);
#pragma unroll
            for (int ks = 0; ks < 16; ks += 2) { acc = __builtin_amdgcn_mfma_f32_16x16x4f32(av[ks], gv[ks], acc, 0, 0, 0); acc2 = __builtin_amdgcn_mfma_f32_16x16x4f32(av[ks + 1], gv[ks + 1], acc2, 0, 0, 0); }
            acc = acc + acc2;
            lds_barrier();
#pragma unroll
            for (int e = 0; e < 4; ++e) { Sl[(4 * fq + e) * 65 + jc] = acc[e];
                if (c + 1 < 64) SB[(size_t)(c + 1) * 4096 + (size_t)(16 * ig + 4 * fq + e) * 64 + jc] = (bf16)f2bf(acc[e]);
                else pw[(size_t)(16 * ig + 4 * fq + e) * 64 + jc] = acc[e]; }
            lds_barrier();
        }
    }
}
__device__ __forceinline__ void p5_post_wave(Frame& F, int wj) {
    const float* Yraw = F.out; const bf16* QB = (const bf16*)(F.out + DO_QB); const float* BON = (const float*)(F.ws + WS_BON);
    const bf16* RKV = (const bf16*)(F.ws + WS_RKV); const bf16* Gg = (const bf16*)(F.ws + WS_G); bf16* MIX = (bf16*)(F.ws + WS_XN); const bf16* SB = (const bf16*)(F.ws + WS_SB);
    const bool prompt = wj < 4096; int bh, cc, g;
    if (prompt) { bh = wj >> 7; cc = (wj >> 1) & 63; g = wj & 1; } else { bh = wj - 4096; cc = 0; g = 0; }
    const int b = bh >> 3, h = bh & 7, lane = F.lane, li = lane & 31, hh = lane >> 5;
    const bool corr = prompt && cc > 0;
    const int m = (prompt ? b * 4096 + cc * 64 + 32 * g : MP + b * 32) + li;
    f32x16 y[2];
#pragma unroll
    for (int mb = 0; mb < 2; ++mb)
#pragma unroll
        for (int rq = 0; rq < 4; ++rq) { const f32x4 v = *(const f32x4*)(Yraw + (size_t)m * 512 + h * 64 + 32 * mb + 8 * rq + 4 * hh);
            y[mb][4 * rq] = v[0]; y[mb][4 * rq + 1] = v[1]; y[mb][4 * rq + 2] = v[2]; y[mb][4 * rq + 3] = v[3]; }
    if (corr) {
        const bf16* sp = SB + ((size_t)(bh * 64 + cc)) * 4096;
#pragma unroll
        for (int ks = 0; ks < 4; ++ks) { const bf16x8 qf = *(const bf16x8*)(QB + (size_t)m * 512 + h * 64 + 16 * ks + 8 * hh);
#pragma unroll
            for (int mb = 0; mb < 2; ++mb) { const bf16x8 sf = *(const bf16x8*)(sp + (size_t)(32 * mb + li) * 64 + 16 * ks + 8 * hh);
                y[mb] = __builtin_amdgcn_mfma_f32_32x32x16_bf16(sf, qf, y[mb], 0, 0, 0); } }
    }
    float s1 = 0.f;
#pragma unroll
    for (int mb = 0; mb < 2; ++mb)
#pragma unroll
        for (int r = 0; r < 16; ++r) s1 += y[mb][r];
    s1 += __shfl_xor(s1, 32); const float mean = s1 * (1.f / 64.f);
    float s2 = 0.f;
#pragma unroll
    for (int mb = 0; mb < 2; ++mb)
#pragma unroll
        for (int r = 0; r < 16; ++r) { const float d = y[mb][r] - mean; s2 += d * d; }
    s2 += __shfl_xor(s2, 32); const float rstd = 1.0f / sqrtf(s2 * (1.f / 64.f) + GN_EPS);
    const float bon = BON[(size_t)m * 8 + h];
    const float* lnw = INP(22) + h * 64; const float* lnb = INP(23) + h * 64;
#pragma unroll
    for (int mb = 0; mb < 2; ++mb)
#pragma unroll
        for (int rq = 0; rq < 4; ++rq) { const int i0 = 32 * mb + 8 * rq + 4 * hh;
            const f32x4 w4 = *(const f32x4*)(lnw + i0), b4 = *(const f32x4*)(lnb + i0);
            const u32x2 vv = *(const u32x2*)(RKV + (size_t)m * 1536 + 1024 + h * 64 + i0), gg = *(const u32x2*)(Gg + (size_t)m * 512 + h * 64 + i0);
            float o[4];
#pragma unroll
            for (int e = 0; e < 4; ++e) { const unsigned vw = e < 2 ? vv.x : vv.y, gw = e < 2 ? gg.x : gg.y;
                const float vf = (e & 1) ? __uint_as_float(vw & 0xffff0000u) : __uint_as_float(vw << 16), gf = (e & 1) ? __uint_as_float(gw & 0xffff0000u) : __uint_as_float(gw << 16);
                o[e] = ((y[mb][4 * rq + e] - mean) * rstd * w4[e] + b4[e] + bon * vf) * gf; }
            u32x2 ow; ow.x = pg8::cvt_pk_bf16(o[0], o[1]); ow.y = pg8::cvt_pk_bf16(o[2], o[3]);
            *(u32x2*)(MIX + (size_t)m * DM + 512 + h * 64 + i0) = ow; }
}
template <int D, int G, int KSTR, int VSTR, class ScoreFn>
__device__ __forceinline__ void attn_group(const LAS unsigned char* Kl, const LAS unsigned char* Vl, const bf16x8 (&qf)[D / 16], f32x16 (&o)[D / 32], float& mrun, float& lrun, int lane, const ScoreFn& sf) {
    const int kr = lane & 31, hh = lane >> 5;
    f32x16 s[G];
#pragma unroll
    for (int kb = 0; kb < G; ++kb) {
#pragma unroll
        for (int e = 0; e < 16; ++e) s[kb][e] = 0.f;
        if (sf.valid(kb)) {
#pragma unroll
            for (int ks = 0; ks < D / 16; ++ks) { const bf16x8 kf = *(const LAS bf16x8*)(Kl + (kb * 32 + kr) * KSTR + (ks * 16 + hh * 8) * 2);
                s[kb] = __builtin_amdgcn_mfma_f32_32x32x16_bf16(kf, qf[ks], s[kb], 0, 0, 0); } }
    }
    float gmax = -INFINITY;
#pragma unroll
    for (int kb = 0; kb < G; ++kb) {
        if (sf.valid(kb)) {
#pragma unroll
            for (int e = 0; e < 16; ++e) { const float v = sf(kb, e, s[kb][e]); s[kb][e] = v; gmax = fmaxf(gmax, v); } }
        else {
#pragma unroll
            for (int e = 0; e < 16; ++e) s[kb][e] = -INFINITY; }
    }
    gmax = fmaxf(gmax, __shfl_xor(gmax, 32));
    const float mn = fmaxf(mrun, gmax); const float alpha = __builtin_amdgcn_exp2f(mrun - mn); mrun = mn;
    float ps = 0.f;
#pragma unroll
    for (int kb = 0; kb < G; ++kb)
#pragma unroll
        for (int e = 0; e < 16; ++e) { const float p = __builtin_amdgcn_exp2f(s[kb][e] - mn); s[kb][e] = p; ps += p; }
    ps += __shfl_xor(ps, 32);
    lrun = lrun * alpha + ps;
#pragma unroll
    for (int db = 0; db < D / 32; ++db)
#pragma unroll
        for (int e = 0; e < 16; ++e) o[db][e] *= alpha;
    const int q4 = (lane & 15) >> 2, p4 = lane & 3, g16 = (lane >> 4) & 1;
#pragma unroll
    for (int kb = 0; kb < G; ++kb) if (sf.valid(kb))
#pragma unroll
        for (int s2 = 0; s2 < 2; ++s2) {
            v4u pw; pw.x = pg8::cvt_pk_bf16(s[kb][8 * s2 + 0], s[kb][8 * s2 + 1]); pw.y = pg8::cvt_pk_bf16(s[kb][8 * s2 + 2], s[kb][8 * s2 + 3]);
            pw.z = pg8::cvt_pk_bf16(s[kb][8 * s2 + 4], s[kb][8 * s2 + 5]); pw.w = pg8::cvt_pk_bf16(s[kb][8 * s2 + 6], s[kb][8 * s2 + 7]);
            const bf16x8 pf = __builtin_bit_cast(bf16x8, pw);
            const int key0 = kb * 32 + 16 * s2 + 4 * hh;
#pragma unroll
            for (int db = 0; db < D / 32; ++db) {
                const LAS unsigned char* va = Vl + (key0 + q4) * VSTR + (32 * db + 16 * g16 + 4 * p4) * 2;
                const bf16x4 v0 = __builtin_amdgcn_ds_read_tr16_b64_v4i16((LAS bf16x4*)va);
                const bf16x4 v1 = __builtin_amdgcn_ds_read_tr16_b64_v4i16((LAS bf16x4*)(va + 8 * VSTR));
                const bf16x8 vf = __builtin_shufflevector(v0, v1, 0, 1, 2, 3, 4, 5, 6, 7);
                o[db] = __builtin_amdgcn_mfma_f32_32x32x16_bf16(vf, pf, o[db], 0, 0, 0);
            }
        }
}
template <int D> __device__ __forceinline__ void attn_store(const f32x16 (&o)[D / 32], float inv, bf16* orow, int lane) {
    const int hh = lane >> 5;
#pragma unroll
    for (int db = 0; db < D / 32; ++db)
#pragma unroll
        for (int rq = 0; rq < 4; ++rq) {
            u32x2 w; w.x = pg8::cvt_pk_bf16(o[db][4 * rq] * inv, o[db][4 * rq + 1] * inv); w.y = pg8::cvt_pk_bf16(o[db][4 * rq + 2] * inv, o[db][4 * rq + 3] * inv);
            *(u32x2*)(orow + 32 * db + 8 * rq + 4 * hh) = w;
        }
}

constexpr int SWA_KSTR = 144, SWA_VSTR = 192;
constexpr int SWA_K_OFF = 0, SWA_V_OFF = 192 * SWA_KSTR  , SWA_LUT_OFF = SWA_V_OFF + 192 * SWA_VSTR  ;
__device__ __forceinline__ int t5_bucket(int rel) {
    const int n = rel < 0 ? -rel : rel;
    int v = n < 8 ? n : (n < 12 ? 8 : (n < 16 ? 9 : (n < 23 ? 10 : (n < 32 ? 11 : (n < 46 ? 12 : (n < 64 ? 13 : (n < 91 ? 14 : 15)))))));
    return (rel > 0 ? 16 : 0) + v;
}
struct SwaScore { const LAS float* lutp; int kb_lo, kb_hi; float sc2;
    __device__ __forceinline__ bool valid(int kb) const { return kb >= kb_lo && kb < kb_hi; }
    __device__ __forceinline__ float operator()(int kb, int e, float raw) const { return raw * sc2 + lutp[kb * 32 + (e & 3) + 8 * (e >> 2)]; } };
__device__ __forceinline__ void swa_build_lut(Frame& F) {
    LAS float* lut = (LAS float*)(F.lds + SWA_LUT_OFF); const float* table = INP(12);
    for (int idx = F.tid; idx < 8 * 256; idx += NTHR) { const int h = idx >> 8, x = idx & 255; const int rel = x - 191;
        lut[idx] = x < 255 ? table[t5_bucket(rel) * 8 + h] * LOG2E : 0.f; }
}
struct SwaPre { v4u kw[3], vw[3]; bf16x8 qf[4]; };
__device__ __forceinline__ void swa_decode(int u, bool& prompt, int& b, int& c, int& kvh) { prompt = u < 512; if (prompt) { b = u >> 7; c = (u >> 1) & 63; kvh = u & 1; } else { b = (u - 512) >> 1; c = 0; kvh = u & 1; } }
__device__ __forceinline__ void swa_prefetch(Frame& F, int u, SwaPre& P) {
    bool prompt; int b, c, kvh; swa_decode(u, prompt, b, c, kvh); if (!prompt) { b = 0; c = 2; }
    const bf16* QKV = (const bf16*)(F.ws + WS_QKV);
#pragma unroll
    for (int it = 0; it < 3; ++it) { const int idx = F.tid + it * NTHR, j = idx >> 3, c8 = idx & 7; int pos = 64 * c - 128 + j; pos = pos < 0 ? 0 : pos;
        const bf16* src = QKV + (size_t)(b * 4096 + pos) * NQKV + 512 + 64 * kvh + 8 * c8; P.kw[it] = *(const v4u*)src; P.vw[it] = *(const v4u*)(src + 128); }
    const int wave = F.wave, lane = F.lane;
    const int mq = b * 4096 + 64 * c + 32 * (wave & 1) + (lane & 31), head = 4 * kvh + (wave >> 1);
#pragma unroll
    for (int ks = 0; ks < 4; ++ks) P.qf[ks] = *(const bf16x8*)(QKV + (size_t)mq * NQKV + head * 64 + ks * 16 + (lane >> 5) * 8);
}
__device__ __forceinline__ void swa_unit(Frame& F, int u, SwaPre& P, int unext) {
    bool prompt; int b, c, kvh; swa_decode(u, prompt, b, c, kvh);
    const bf16* QKV = (const bf16*)(F.ws + WS_QKV); bf16* MIX = (bf16*)(F.ws + WS_XN);
    LAS unsigned char* Kl = F.lds + SWA_K_OFF; LAS unsigned char* Vl = F.lds + SWA_V_OFF;
    const int wave = F.wave, lane = F.lane;
    lds_barrier();
    bf16x8 qf[4];
    if (prompt) {
#pragma unroll
        for (int it = 0; it < 3; ++it) { const int idx = F.tid + it * NTHR, j = idx >> 3, c8 = idx & 7; const bool valid = 64 * c - 128 + j >= 0; const v4u z = (v4u){0u, 0u, 0u, 0u};
            *(LAS v4u*)(Kl + j * SWA_KSTR + c8 * 16) = valid ? P.kw[it] : z; *(LAS v4u*)(Vl + j * SWA_VSTR + c8 * 16) = valid ? P.vw[it] : z; }
#pragma unroll
        for (int ks = 0; ks < 4; ++ks) qf[ks] = P.qf[ks];
    } else {
        for (int idx = F.tid; idx < 192 * 8; idx += NTHR) {
            const int j = idx >> 3, c8 = idx & 7; v4u kw = (v4u){0u, 0u, 0u, 0u}, vw = (v4u){0u, 0u, 0u, 0u};
            if (j < 128) { const float* sk = INP(3) + ((size_t)(b * 128 + j)) * 128 + 64 * kvh + 8 * c8; const float* sv = INP(4) + ((size_t)(b * 128 + j)) * 128 + 64 * kvh + 8 * c8;
                const f32x4 k0 = *(const f32x4*)sk, k1 = *(const f32x4*)(sk + 4), v0 = *(const f32x4*)sv, v1 = *(const f32x4*)(sv + 4);
                kw = (v4u){pk2(k0[0], k0[1]), pk2(k0[2], k0[3]), pk2(k1[0], k1[1]), pk2(k1[2], k1[3])}; vw = (v4u){pk2(v0[0], v0[1]), pk2(v0[2], v0[3]), pk2(v1[0], v1[1]), pk2(v1[2], v1[3])}; }
            else if (j < 160) { const bf16* src = QKV + (size_t)(MP + b * 32 + (j - 128)) * NQKV + 512 + 64 * kvh + 8 * c8; kw = *(const v4u*)src; vw = *(const v4u*)(src + 128); }
            *(LAS v4u*)(Kl + j * SWA_KSTR + c8 * 16) = kw; *(LAS v4u*)(Vl + j * SWA_VSTR + c8 * 16) = vw; }
        const int mqs = MP + b * 32 + (lane & 31), heads = 4 * kvh + (wave & 3);
#pragma unroll
        for (int ks = 0; ks < 4; ++ks) qf[ks] = *(const bf16x8*)(QKV + (size_t)mqs * NQKV + heads * 64 + ks * 16 + (lane >> 5) * 8);
    }
    lds_barrier();
    swa_prefetch(F, unext, P);
    const bool active = prompt || wave < 4;
    if (active) {
        const int head = 4 * kvh + (prompt ? (wave >> 1) : wave), q0 = prompt ? 32 * (wave & 1) : 0;
        const int mq = (prompt ? b * 4096 + 64 * c : MP + b * 32) + q0 + (lane & 31);
        f32x16 o[2];
#pragma unroll
        for (int db = 0; db < 2; ++db)
#pragma unroll
            for (int e = 0; e < 16; ++e) o[db][e] = 0.f;
        const float sink2 = INP(11)[head] * LOG2E;
        float mrun = sink2, lrun = 0.f;
        SwaScore sf; sf.lutp = (const LAS float*)(F.lds + SWA_LUT_OFF) + head * 256 + 63 - (q0 + (lane & 31)) + 4 * (lane >> 5); sf.sc2 = 0.125f * LOG2E;
        if (prompt) { sf.kb_lo = c < 2 ? 4 - 2 * c : 0; sf.kb_hi = 6; } else { sf.kb_lo = 0; sf.kb_hi = 5; }
        attn_group<64, 6, SWA_KSTR, SWA_VSTR>(Kl, Vl, qf, o, mrun, lrun, lane, sf);
        const float den = lrun + __builtin_amdgcn_exp2f(sink2 - mrun);
        attn_store<64>(o, 1.0f / den, MIX + (size_t)mq * DM + head * 64, lane);
    }
}
__device__ __forceinline__ void swa_units(Frame& F, int first, int stride, int end) {
    if (first >= end) return;
    SwaPre P; swa_prefetch(F, first, P);
    for (int u = first; u < end; u += stride) swa_unit(F, u, P, u + stride < end ? u + stride : u);
}

constexpr int CA_KSTR = 272, CA_VSTR = 320, CA_K_OFF = 0, CA_V_OFF = 128 * CA_KSTR  ;
struct PlainScore { float sc2; __device__ __forceinline__ bool valid(int) const { return true; } __device__ __forceinline__ float operator()(int, int, float raw) const { return raw * sc2; } };
__device__ __forceinline__ void ca_unit(Frame& F, int u) {
    const bool prompt = u < 256; const int hd = u & 3; int mbase, bidx;
    if (prompt) { const int tile = u >> 2; mbase = tile * 256; bidx = tile >> 4; } else { const int b = (u - 256) >> 2; mbase = MP + b * 32; bidx = 4 + b; }
    const bf16* QC = (const bf16*)(F.ws + WS_RKV); bf16* OC = (bf16*)(F.ws + WS_XN);
    const bf16* MKB = (const bf16*)(F.ws + WS_MKB) + (size_t)bidx * 256 * 512 + hd * 128; const bf16* MVB = (const bf16*)(F.ws + WS_MVB) + (size_t)bidx * 256 * 512 + hd * 128;
    LAS unsigned char* Kl = F.lds + CA_K_OFF; LAS unsigned char* Vl = F.lds + CA_V_OFF;
    const int wave = F.wave, lane = F.lane; const bool active = prompt || wave == 0;
    const int mq = mbase + (prompt ? 32 * wave : 0) + (lane & 31);
    bf16x8 qf[8]; f32x16 o[4]; float mrun = -INFINITY, lrun = 0.f;
    if (active) {
#pragma unroll
        for (int ks = 0; ks < 8; ++ks) qf[ks] = *(const bf16x8*)(QC + (size_t)mq * 512 + hd * 128 + ks * 16 + (lane >> 5) * 8);
    }
#pragma unroll
    for (int db = 0; db < 4; ++db)
#pragma unroll
        for (int e = 0; e < 16; ++e) o[db][e] = 0.f;
    PlainScore sf; sf.sc2 = 0.08838834764831845f * LOG2E;
    for (int g = 0; g < 2; ++g) {
        lds_barrier();
        for (int idx = F.tid; idx < 128 * 16; idx += NTHR) { const int j = idx >> 4, c8 = idx & 15;
            *(LAS v4u*)(Kl + j * CA_KSTR + c8 * 16) = *(const v4u*)(MKB + (size_t)(g * 128 + j) * 512 + 8 * c8);
            *(LAS v4u*)(Vl + j * CA_VSTR + c8 * 16) = *(const v4u*)(MVB + (size_t)(g * 128 + j) * 512 + 8 * c8); }
        lds_barrier();
        if (active) attn_group<128, 4, CA_KSTR, CA_VSTR>(Kl, Vl, qf, o, mrun, lrun, lane, sf);
    }
    if (active) attn_store<128>(o, 1.0f / lrun, OC + (size_t)mq * 512 + hd * 128, lane);
}

__device__ __forceinline__ void p11_final(Frame& F) {
    const int gw = F.vcu * NWAVES + F.wave, NGW = F.G * NWAVES; const float* PART = (const float*)(F.ws + WS_PART3); const float* g = INP(34);
    for (int m = gw; m < MALL; m += NGW) {
        const f32x4 p0 = *(const f32x4*)(PART + (size_t)m * 16), p1 = *(const f32x4*)(PART + (size_t)m * 16 + 4), p2 = *(const f32x4*)(PART + (size_t)m * 16 + 8), p3 = *(const f32x4*)(PART + (size_t)m * 16 + 12);
        const float ss = ((p0[0] + p0[1]) + (p0[2] + p0[3])) + ((p1[0] + p1[1]) + (p1[2] + p1[3])) + ((p2[0] + p2[1]) + (p2[2] + p2[3])) + ((p3[0] + p3[1]) + (p3[2] + p3[3]));
        const float rs = 1.0f / sqrtf(ss * (1.f / 1024.f) + NORM_EPS);
        f32x4* xr = (f32x4*)(F.out + (size_t)m * DM) + F.lane; const f32x4* gr = (const f32x4*)g + F.lane;
#pragma unroll
        for (int j = 0; j < 4; ++j) { f32x4 v = xr[64 * j]; const f32x4 gg = gr[64 * j]; v = v * rs; v[0] *= gg[0]; v[1] *= gg[1]; v[2] *= gg[2]; v[3] *= gg[3]; xr[64 * j] = v; }
    }
}

#ifndef PROBE_ATT_REP
#define PROBE_ATT_REP 1
#endif
#ifndef PROBE_SCAN_REP
#define PROBE_SCAN_REP 1
#endif
#ifndef PROBE_PHASE
#define PROBE_PHASE -1
#endif
#ifndef MK_SPLIT
#define MK_SPLIT 0
#endif
constexpr int N_PHASES = 14;
struct Args { const float* in[35]; float* out; unsigned char* ws; int ph_lo, ph_hi; };
static_assert(sizeof(Args) == 35 * 8 + 8 + 8 + 8, "Args has no padding");

__global__ void __launch_bounds__(NTHR, 2) hymba_fwd(Args args) {
    extern __shared__ __attribute__((aligned(16))) unsigned char lds_raw[];
    Frame F;
    F.lds = (LAS unsigned char*)lds_raw; F.MISC = (volatile LAS unsigned*)(F.lds + MISC_OFF);
    F.tid = threadIdx.x; F.lane = F.tid & 63; F.wave = __builtin_amdgcn_readfirstlane(F.tid >> 6);
    F.G = gridDim.x; { const int bx = blockIdx.x; F.vcu = (F.G % 8 == 0) ? (bx % 8) * (F.G / 8) + bx / 8 : bx; }
    F.in = (InTab)__builtin_amdgcn_kernarg_segment_ptr();
    F.out = args.out; F.ws = args.ws; F.ctl = (gu32*)(args.ws + WS_CTL);
    unsigned char* ws = args.ws;
    for (int u = F.tid; u < (LDS_BYTES - LDSCTL_OFF) / 4; u += NTHR) ((LAS unsigned*)(F.lds + LDSCTL_OFF))[u] = 0u;
    __syncthreads();
    XcdBarrier bar; bar.bar = (unsigned*)(F.ctl + CW_BAR); bar.x = 0; bar.st = nullptr;
    const int lo = args.ph_lo, hi = args.ph_hi;
    if (hi - lo > 1) bar = xcd_barrier_post((unsigned*)(F.ctl + CW_BAR), F.MISC + 8);
#define IN(k) (lo <= (k) && (k) < hi)
#define FRESH() do { int t_ = threadIdx.x; asm volatile("" : "+v"(t_)); F.tid = t_; F.lane = t_ & 63; F.wave = __builtin_amdgcn_readfirstlane(t_ >> 6); } while (0)
#define SEAM(k) do { if (IN(k) && IN((k) + 1)) xcd_barrier(bar); } while (0)
    const int bx = (int)blockIdx.x;

    if (IN(0)) { FRESH(); p0_prologue(F); } SEAM(0);
    if (IN(1)) { FRESH();
        { pg8::Gemm g{(const pg8::bf16_t*)(ws + WS_XN), (const pg8::bf16_t*)(ws + WS_WIN), MALL, 2560, 1024}; pg8::StaticOrder S; S.init(MP, 2560, F.G, bx);
          EpiIn E{(bf16*)(ws + WS_QKV), (bf16*)(ws + WS_ZR), F.out};
          pg8::gemm_phase<EpiIn, pg8::StaticOrder, true, true>(F.lds, g, S, E);
          FRESH(); small_gemm(F, g.A, g.Bt, 1024, 2560, E); }
        { pg8::Gemm g{(const pg8::bf16_t*)(ws + WS_MN), (const pg8::bf16_t*)(ws + WS_WMKV), 1024, 1024, 1024}; pg8::StaticOrder S; S.init(1024, 1024, F.G, (bx + 96) % F.G);
          EpiMemKV E{(bf16*)(ws + WS_MKB), (bf16*)(ws + WS_MVB), F.out};
          pg8::gemm_phase<EpiMemKV, pg8::StaticOrder, true, true>(F.lds, g, S, E); }
        if (F.G >= 256 && bx >= 192) { FRESH(); __syncthreads(); p0_late_weights(F, 0, (bx - 192) * NWAVES + F.wave, (F.G - 192) * NWAVES); }
        else if (F.G < 256) { FRESH(); __syncthreads(); p0_late_weights(F, 0, bx * NWAVES + F.wave, F.G * NWAVES); }
    } SEAM(1);
    if (IN(2)) { FRESH(); p2_prep(F); } SEAM(2);
    if (IN(3)) { FRESH();
        pg8::Gemm g{(const pg8::bf16_t*)(ws + WS_AP), (const pg8::bf16_t*)(ws + WS_WLORA), MALL, 1536, 256}; pg8::StaticOrder S; S.init(MP, 1536, F.G, bx);
        EpiLora E{(float*)(ws + WS_LW), (bf16*)(F.out + DO_AH), (bf16*)(ws + WS_G), INP(14), INP(16)};
        pg8::gemm_phase<EpiLora, pg8::StaticOrder, true, true>(F.lds, g, S, E);
        FRESH(); small_gemm(F, g.A, g.Bt, 256, 1536, E);
    } SEAM(3);
    if (IN(4)) { FRESH();
        if (F.vcu < 2048) { CkRaw R; ck_prefetch(F, F.vcu, R);
            for (int j = F.vcu; j < 2048; j += F.G) p4_chunk_job(F, j, R, j + F.G < 2048 ? j + F.G : j); }
    } SEAM(4);
    if (IN(5)) { FRESH();
        if (F.G >= 256) {
            if (F.vcu < 128) { for (int rep_ = 0; rep_ < PROBE_SCAN_REP; ++rep_) p5_chain_job(F, F.vcu); lds_barrier(); swa_build_lut(F); swa_units(F, 400 + F.vcu, 128, 528); }
            else { const int r = F.vcu - 128, nr = F.G - 128;
                for (int j = r; j < 64; j += nr) p4_sample_scan_job(F, j);
                lds_barrier(); swa_build_lut(F); swa_units(F, r, nr, 400); }
        } else {
            for (int j = F.vcu; j < 128; j += F.G) p5_chain_job(F, j);
            for (int j = F.vcu; j < 64; j += F.G) p4_sample_scan_job(F, j);
            lds_barrier(); swa_build_lut(F); swa_units(F, F.vcu, F.G, 528);
        }
    } SEAM(5);
    if (IN(6)) { FRESH(); for (int wj = F.vcu * NWAVES + F.wave; wj < 4096 + 64; wj += F.G * NWAVES) p5_post_wave(F, wj); } SEAM(6);
    if (IN(7)) { FRESH();
        pg8::Gemm g{(const pg8::bf16_t*)(ws + WS_XN), (const pg8::bf16_t*)(ws + WS_WOUT), MALL, 1024, 1024}; pg8::StaticOrder S; S.init(MP, 1024, F.G, bx);
        EpiRes E{INP(0), INP(1), nullptr, nullptr, (bf16*)(ws + WS_XB), (float*)(ws + WS_PART1)};
        pg8::gemm_phase<EpiRes, pg8::StaticOrder, true, true>(F.lds, g, S, E);
        FRESH(); small_gemm(F, g.A, g.Bt, 1024, 1024, E);
    } SEAM(7);
    if (IN(8)) { FRESH();
        pg8::Gemm g{(const pg8::bf16_t*)(ws + WS_XB), (const pg8::bf16_t*)(ws + WS_WCQ), MALL, 512, 1024}; pg8::StaticOrder S; S.init(MP, 512, F.G, bx);
        EpiNormBf16<0> E{(bf16*)(ws + WS_RKV), 512, (const float*)(ws + WS_PART1), 1.0f};
        pg8::gemm_phase<EpiNormBf16<0>, pg8::StaticOrder, true, true>(F.lds, g, S, E);
        if (F.G >= 256 && bx >= 128 && bx < 224) { FRESH(); __syncthreads(); p0_late_weights(F, 1, (bx - 128) * NWAVES + F.wave, 96 * NWAVES); }
        else if (F.G < 256) { FRESH(); __syncthreads(); p0_late_weights(F, 1, bx * NWAVES + F.wave, F.G * NWAVES); }
        FRESH(); small_gemm(F, g.A, g.Bt, 1024, 512, E);
    } SEAM(8);
    if (IN(9)) { FRESH(); for (int u = F.vcu; u < 288; u += F.G) ca_unit(F, u); } SEAM(9);
    if (IN(10)) { FRESH();
        pg8::Gemm g{(const pg8::bf16_t*)(ws + WS_XN), (const pg8::bf16_t*)(ws + WS_WCO), MALL, 1024, 512}; pg8::StaticOrder S; S.init(MP, 1024, F.G, bx);
        EpiRes E{nullptr, nullptr, (const bf16*)(ws + WS_XB), nullptr, (bf16*)(ws + WS_XB), (float*)(ws + WS_PART2)};
        pg8::gemm_phase<EpiRes, pg8::StaticOrder, true, true>(F.lds, g, S, E);
        FRESH(); small_gemm(F, g.A, g.Bt, 512, 1024, E);
    } SEAM(10);
    if (IN(11)) { FRESH();
        pg8::Gemm g{(const pg8::bf16_t*)(ws + WS_XB), (const pg8::bf16_t*)(ws + WS_WUP), MALL, 4096, 1024}; pg8::StaticOrder S; S.init(MP, 4096, F.G, bx);
        EpiNormBf16<1> E{(bf16*)(ws + WS_H), 4096, (const float*)(ws + WS_PART2), 1.0f};
        pg8::gemm_phase<EpiNormBf16<1>, pg8::StaticOrder, true, true>(F.lds, g, S, E);
        FRESH(); small_gemm(F, g.A, g.Bt, 1024, 4096, E);
    } SEAM(11);
    if (IN(12)) { FRESH();
        pg8::Gemm g{(const pg8::bf16_t*)(ws + WS_H), (const pg8::bf16_t*)(ws + WS_WDN), MALL, 1024, 4096}; pg8::StaticOrder S; S.init(MP, 1024, F.G, bx);
        EpiRes E{nullptr, nullptr, (const bf16*)(ws + WS_XB), F.out, nullptr, (float*)(ws + WS_PART3)};
        pg8::gemm_phase<EpiRes, pg8::StaticOrder, true, true>(F.lds, g, S, E);
        FRESH(); small_gemm(F, g.A, g.Bt, 4096, 1024, E);
    } SEAM(12);
    if (IN(13)) { FRESH(); p11_final(F); }
#undef IN
#undef SEAM
}

extern "C" void kernel_launch(void* const* d_in, const int* in_sizes, int n_in, void* d_out, int out_size, void* d_ws, size_t ws_size, hipStream_t stream) {
    static int grid = 0;
    if (grid == 0) {
        if (n_in != 35 || out_size != (int)OUT_TOTAL || ws_size < WS_END) { fprintf(stderr, "kernel_launch: unexpected shapes: n_in %d out %d ws %zu\n", n_in, out_size, ws_size); grid = -1; return; }
        int dev = 0, cus = 0, per_cu = 0;
        if (hipGetDevice(&dev) != hipSuccess || hipDeviceGetAttribute(&cus, hipDeviceAttributeMultiprocessorCount, dev) != hipSuccess) { grid = -1; return; }
        if (hipFuncSetAttribute((const void*)hymba_fwd, hipFuncAttributeMaxDynamicSharedMemorySize, LDS_BYTES) != hipSuccess) { fprintf(stderr, "kernel_launch: hipFuncSetAttribute failed\n"); grid = -1; return; }
        if (hipOccupancyMaxActiveBlocksPerMultiprocessor(&per_cu, (const void*)hymba_fwd, NTHR, LDS_BYTES) != hipSuccess || per_cu < 1)
            fprintf(stderr, "kernel_launch: occupancy query reports %d workgroups per CU\n", per_cu);
        (void)hipGetLastError();
        grid = cus;
    }
    if (grid < 0) return;
    if (hipMemsetAsync((char*)d_ws + WS_CTL, 0, CTL_ZERO_BYTES, stream) != hipSuccess) { fprintf(stderr, "kernel_launch: memset failed\n"); return; }
    Args a{};
    for (int i = 0; i < 35; ++i) a.in[i] = (const float*)d_in[i];
    a.out = (float*)d_out; a.ws = (unsigned char*)d_ws;
#if MK_SPLIT
    for (int p = 0; p < N_PHASES; ++p) { a.ph_lo = p; a.ph_hi = p + 1; hipLaunchKernelGGL(hymba_fwd, dim3(grid), dim3(NTHR), LDS_BYTES, stream, a); }
#elif PROBE_PHASE >= 0
    a.ph_lo = 0; a.ph_hi = PROBE_PHASE + 1; hipLaunchKernelGGL(hymba_fwd, dim3(grid), dim3(NTHR), LDS_BYTES, stream, a);
    (void)hipMemsetAsync((char*)d_ws + WS_CTL, 0, CTL_ZERO_BYTES, stream);
    a.ph_lo = PROBE_PHASE; a.ph_hi = N_PHASES; hipLaunchKernelGGL(hymba_fwd, dim3(grid), dim3(NTHR), LDS_BYTES, stream, a);
#else
    a.ph_lo = 0; a.ph_hi = N_PHASES; hipLaunchKernelGGL(hymba_fwd, dim3(grid), dim3(NTHR), LDS_BYTES, stream, a);
#endif
    const hipError_t le = hipPeekAtLastError();
    if (le != hipSuccess) fprintf(stderr, "kernel_launch: launch failed: %s\n", hipGetErrorName(le));
}
```
